# Optimizing an MI355X kernel written in HIP

```python
import math
import jax
import jax.numpy as jnp
from jax import lax
import numpy as np

D_MODEL = 2048
BATCH = 4
SEQ = 2048
DEPTH = 4

GRID_W = 64
CTX_LEN = 256
D_HEAD = 128
ATTN_Q_HEADS = 8
ATTN_KV_HEADS = 2
ATTN_GROUP = ATTN_Q_HEADS // ATTN_KV_HEADS
WINDOW = 128
ATTN_BLOCK = 128
GDN_HEADS = 8
GDN_DK = 128
GDN_DV = 128
GDN_CHUNK = 64
CONV_W = 5
D_FF = 4 * D_MODEL
ROPE_BASE = 10000.0
AXIS_ROT = D_HEAD // 2
EPS = 1e-6
NEG_INF = -1e30

ATTN_Q = ATTN_Q_HEADS * D_HEAD
ATTN_KV = ATTN_KV_HEADS * D_HEAD
GDN_QK = GDN_HEADS * GDN_DK
GDN_V = GDN_HEADS * GDN_DV
GDN_QKV = 2 * GDN_QK + GDN_V
GDN_AB = 4 * GDN_HEADS
IN_OFFSETS = (ATTN_Q, ATTN_Q + ATTN_KV, ATTN_Q + 2 * ATTN_KV, ATTN_Q + 2 * ATTN_KV + GDN_QKV,
              ATTN_Q + 2 * ATTN_KV + GDN_QKV + GDN_V)
D_IN = ATTN_Q + 2 * ATTN_KV + GDN_QKV + GDN_V + GDN_AB
MIX_OUT = ATTN_Q + GDN_V

kernel_name = "hymba_swa_gdn_sqrelu_prefix_dit"


def rmsnorm(x, gain):
    xf = x.astype(jnp.float32)
    y = xf * lax.rsqrt(jnp.mean(xf * xf, axis=-1, keepdims=True) + EPS)
    return (y * gain.astype(jnp.float32)).astype(x.dtype)


def modulate(h, shift, scale):
    return h * (1 + scale) + shift


def axial_rope_tables(n_tokens, dtype):
    rows = n_tokens // GRID_W
    row = jnp.repeat(jnp.arange(rows, dtype=jnp.float32), GRID_W)
    col = jnp.tile(jnp.arange(GRID_W, dtype=jnp.float32), rows)
    inv_freq = ROPE_BASE ** (-jnp.arange(0, AXIS_ROT, 2, dtype=jnp.float32) / AXIS_ROT)
    ang = jnp.concatenate([row[:, None] * inv_freq, col[:, None] * inv_freq], axis=-1)
    return jnp.cos(ang).astype(dtype), jnp.sin(ang).astype(dtype)


def axial_rope(x, cos, sin):
    half = AXIS_ROT // 2

    def rot(t, c, s):
        t1, t2 = t[..., :half], t[..., half:]
        return jnp.concatenate([t1 * c - t2 * s, t2 * c + t1 * s], axis=-1)

    cr, cc = cos[None, :, None, :half], cos[None, :, None, half:]
    sr, sc = sin[None, :, None, :half], sin[None, :, None, half:]
    return jnp.concatenate([rot(x[..., :AXIS_ROT], cr, sr), rot(x[..., AXIS_ROT:], cc, sc)], axis=-1)


def windowed_attention(q, k, v, kc, vc, sink):
    B, L = q.shape[:2]
    LC = kc.shape[1]
    nb = L // ATTN_BLOCK
    scale = D_HEAD ** -0.5
    qb = q.reshape(B, nb, ATTN_BLOCK, ATTN_KV_HEADS, ATTN_GROUP, D_HEAD)

    def band(t):
        tp = jnp.pad(t, ((0, 0), (ATTN_BLOCK, ATTN_BLOCK), (0, 0), (0, 0)))
        parts = [tp[:, s * ATTN_BLOCK: s * ATTN_BLOCK + L].reshape(B, nb, ATTN_BLOCK, ATTN_KV_HEADS, D_HEAD)
                 for s in range(3)]
        return jnp.concatenate(parts, axis=2)

    kb, vb = band(k), band(v)
    qi = jnp.arange(ATTN_BLOCK)
    kj = jnp.arange(3 * ATTN_BLOCK) - ATTN_BLOCK
    rel = kj[None, :] - qi[:, None]
    key_pos = jnp.arange(nb)[:, None] * ATTN_BLOCK + kj[None, :]
    allowed = (jnp.abs(rel) <= WINDOW)[None] & ((key_pos >= 0) & (key_pos < L))[:, None, :]
    s_loc = jnp.einsum('bnqhgd,bnkhd->bnhgqk', qb, kb).astype(jnp.float32) * scale
    s_loc = jnp.where(allowed[None, :, None, None], s_loc, NEG_INF)
    s_ctx = jnp.einsum('bnqhgd,bchd->bnhgqc', qb, kc).astype(jnp.float32) * scale
    s_sink = jnp.broadcast_to(sink.astype(jnp.float32).reshape(ATTN_KV_HEADS, ATTN_GROUP, 1, 1),
                              s_ctx.shape[:-1] + (1,))
    p = jax.nn.softmax(jnp.concatenate([s_loc, s_ctx, s_sink], axis=-1), axis=-1).astype(q.dtype)
    nk = 3 * ATTN_BLOCK
    o = (jnp.einsum('bnhgqk,bnkhd->bnqhgd', p[..., :nk], vb)
         + jnp.einsum('bnhgqc,bchd->bnqhgd', p[..., nk:nk + LC], vc))
    return o.reshape(B, L, ATTN_Q)


def context_attention(q, k, v, sink):
    B, LC = q.shape[:2]
    qg = q.reshape(B, LC, ATTN_KV_HEADS, ATTN_GROUP, D_HEAD)
    s = jnp.einsum('bqhgd,bkhd->bhgqk', qg, k).astype(jnp.float32) * D_HEAD ** -0.5
    s_sink = jnp.broadcast_to(sink.astype(jnp.float32).reshape(1, ATTN_KV_HEADS, ATTN_GROUP, 1, 1),
                              s.shape[:-1] + (1,))
    p = jax.nn.softmax(jnp.concatenate([s, s_sink], axis=-1), axis=-1).astype(q.dtype)
    o = jnp.einsum('bhgqk,bkhd->bqhgd', p[..., :LC], v)
    return o.reshape(B, LC, ATTN_Q)


def short_conv(x, w):
    n = x.shape[1]
    pad = CONV_W // 2
    xp = jnp.pad(x, ((0, 0), (pad, pad), (0, 0)))
    y = xp[:, 0:n] * w[0]
    for j in range(1, CONV_W):
        y = y + xp[:, j:j + n] * w[j]
    return jax.nn.silu(y)


def l2norm(t):
    return t * lax.rsqrt(jnp.sum(t * t, axis=-1, keepdims=True) + EPS)


def gdn_chunk(q, k, v, g, beta, s0):
    B, L, H, DK = q.shape
    DV = v.shape[-1]
    C = GDN_CHUNK
    N = L // C

    def chunks(t):
        return jnp.moveaxis(t.reshape((B, N, C, H) + t.shape[3:]), 3, 1)

    q, k, v, g, beta = chunks(q), chunks(k), chunks(v), chunks(g), chunks(beta)
    gc = jnp.cumsum(g, axis=-1)
    idx = jnp.arange(C)
    lower = idx[:, None] >= idx[None, :]
    strict = idx[:, None] > idx[None, :]
    diff = gc[..., :, None] - gc[..., None, :]
    decay = jnp.where(lower, jnp.exp(jnp.where(lower, diff, 0.0)), 0.0)
    kb = k * beta[..., None]
    vb = v * beta[..., None]
    a = jnp.where(strict, jnp.einsum('bhnid,bhnjd->bhnij', kb, k) * decay, 0.0)
    tmat = a + jnp.eye(C, dtype=a.dtype)
    rhs = jnp.concatenate([vb, kb * jnp.exp(gc)[..., None]], axis=-1)
    sol = lax.linalg.triangular_solve(tmat, rhs, left_side=True, lower=True, unit_diagonal=True)
    u, w = sol[..., :DV], sol[..., DV:]
    qk = jnp.einsum('bhnid,bhnjd->bhnij', q, k) * decay
    q_dec = q * jnp.exp(gc)[..., None]
    k_dec = k * jnp.exp(gc[..., -1:] - gc)[..., None]
    g_last = jnp.exp(gc[..., -1])
    xs = tuple(jnp.moveaxis(t, 2, 0) for t in (q_dec, k_dec, u, w, qk, g_last))

    def step(s, inp):
        qd, kd, ui, wi, qki, gl = inp
        v_new = ui - jnp.einsum('bhcd,bhde->bhce', wi, s)
        o = jnp.einsum('bhcd,bhde->bhce', qd, s) + jnp.einsum('bhij,bhje->bhie', qki, v_new)
        s = s * gl[..., None, None] + jnp.einsum('bhcd,bhce->bhde', kd, v_new)
        return s, o

    s_fin, o = lax.scan(step, s0, xs)
    o = jnp.moveaxis(jnp.moveaxis(o, 0, 2), 1, 3).reshape(B, L, H, DV)
    return o, s_fin


def gated_deltanet(qkv_c, qkv_l, ab_c, ab_l, a_log, dt_bias):
    def prep(qkv, ab):
        B, T = qkv.shape[:2]
        qkv = qkv.astype(jnp.float32)
        ab = ab.astype(jnp.float32).reshape(B, T, 2, 2, GDN_HEADS)
        q, k, v = jnp.split(qkv, [GDN_QK, 2 * GDN_QK], axis=-1)
        q = l2norm(q.reshape(B, T, GDN_HEADS, GDN_DK)) * GDN_DK ** -0.5
        k = l2norm(k.reshape(B, T, GDN_HEADS, GDN_DK))
        v = v.reshape(B, T, GDN_HEADS, GDN_DV)
        g = -jnp.exp(a_log.astype(jnp.float32)) * jax.nn.softplus(ab[:, :, :, 0] + dt_bias.astype(jnp.float32))
        beta = jax.nn.sigmoid(ab[:, :, :, 1])
        return q, k, v, g, beta

    pc, pl = prep(qkv_c, ab_c), prep(qkv_l, ab_l)
    B = qkv_c.shape[0]
    s0 = jnp.zeros((B, GDN_HEADS, GDN_DK, GDN_DV), jnp.float32)
    outs_c, outs_l = [], []
    for d in range(2):
        def sel(p):
            q, k, v, g, beta = p
            t = (q, k, v, g[:, :, d], beta[:, :, d])
            return tuple(jnp.flip(a, axis=1) for a in t) if d == 1 else t
        oc, sc = gdn_chunk(*sel(pc), s0)
        ol, _ = gdn_chunk(*sel(pl), sc)
        if d == 1:
            oc, ol = jnp.flip(oc, axis=1), jnp.flip(ol, axis=1)
        outs_c.append(oc)
        outs_l.append(ol)
    return outs_c[0] + outs_c[1], outs_l[0] + outs_l[1]


def gated_rmsnorm(o, gate, gain):
    B, T = o.shape[:2]
    y = o * lax.rsqrt(jnp.mean(o * o, axis=-1, keepdims=True) + EPS) * gain.astype(jnp.float32)
    y = y * jax.nn.silu(gate.astype(jnp.float32)).reshape(B, T, GDN_HEADS, GDN_DV)
    return y.reshape(B, T, GDN_V).astype(gate.dtype)


def mixer(hc, hl, w_in, conv_w, a_log, dt_bias, gdn_norm, sink, w_out, cos, sin, last):
    B, LC = hc.shape[:2]
    z = jnp.concatenate([hc, hl], axis=1) @ w_in
    T = z.shape[1]
    aq, ak, av, gqkv, ggate, gab = jnp.split(z, IN_OFFSETS, axis=-1)
    aq = aq.reshape(B, T, ATTN_Q_HEADS, D_HEAD)
    ak = ak.reshape(B, T, ATTN_KV_HEADS, D_HEAD)
    av = av.reshape(B, T, ATTN_KV_HEADS, D_HEAD)
    q_l = axial_rope(aq[:, LC:], cos, sin)
    k_l = axial_rope(ak[:, LC:], cos, sin)
    o_attn_l = windowed_attention(q_l, k_l, av[:, LC:], ak[:, :LC], av[:, :LC], sink)
    qkv_c = short_conv(gqkv[:, :LC], conv_w)
    qkv_l = short_conv(gqkv[:, LC:], conv_w)
    o_gdn_c, o_gdn_l = gated_deltanet(qkv_c, qkv_l, gab[:, :LC], gab[:, LC:], a_log, dt_bias)
    o_gdn_l = gated_rmsnorm(o_gdn_l, ggate[:, LC:], gdn_norm)
    out_l = jnp.concatenate([o_attn_l, o_gdn_l], axis=-1) @ w_out
    if last:
        return None, out_l
    o_attn_c = context_attention(aq[:, :LC], ak[:, :LC], av[:, :LC], sink)
    o_gdn_c = gated_rmsnorm(o_gdn_c, ggate[:, :LC], gdn_norm)
    out_c = jnp.concatenate([o_attn_c, o_gdn_c], axis=-1) @ w_out
    return out_c, out_l


def squared_relu_mlp(h, w1, w2):
    return jnp.square(jax.nn.relu(h @ w1)) @ w2


def setup_inputs(seed: int = 0) -> dict:
    key = jax.random.key(seed)
    ks = jax.random.split(key, 18)
    f32 = jnp.float32

    def nrm(k, shape, scale):
        return jax.random.normal(k, shape, f32) * scale

    dt = jnp.exp(jax.random.uniform(ks[9], (DEPTH, 2, GDN_HEADS), f32, math.log(1e-3), math.log(1e-1)))
    return {
        "x": nrm(ks[0], (BATCH, SEQ, D_MODEL), 1.0),
        "c": nrm(ks[1], (BATCH, D_MODEL), 1.0),
        "ctx": nrm(ks[2], (BATCH, CTX_LEN, D_MODEL), 1.0),
        "c_ctx": nrm(ks[3], (D_MODEL,), 1.0),
        "w_ada": nrm(ks[4], (DEPTH, D_MODEL, 6 * D_MODEL), D_MODEL ** -0.5),
        "b_ada": nrm(ks[5], (DEPTH, 6 * D_MODEL), 0.02),
        "norm_mix": 1.0 + nrm(ks[6], (DEPTH, D_MODEL), 0.02),
        "w_in": nrm(ks[7], (DEPTH, D_MODEL, D_IN), D_MODEL ** -0.5),
        "conv_w": nrm(ks[8], (DEPTH, CONV_W, GDN_QKV), CONV_W ** -0.5),
        "a_log": jnp.log(jax.random.uniform(ks[10], (DEPTH, 2, GDN_HEADS), f32, 1.0, 16.0)),
        "dt_bias": dt + jnp.log(-jnp.expm1(-dt)),
        "gdn_norm": 1.0 + nrm(ks[11], (DEPTH, GDN_DV), 0.02),
        "attn_sink": nrm(ks[12], (DEPTH, ATTN_Q_HEADS), 0.5),
        "w_out": nrm(ks[13], (DEPTH, MIX_OUT, D_MODEL), MIX_OUT ** -0.5),
        "norm_ffn": 1.0 + nrm(ks[14], (DEPTH, D_MODEL), 0.02),
        "w_ff1": nrm(ks[15], (DEPTH, D_MODEL, D_FF), D_MODEL ** -0.5),
        "w_ff2": nrm(ks[16], (DEPTH, D_FF, D_MODEL), D_FF ** -0.5),
        "norm_final": 1.0 + nrm(ks[17], (D_MODEL,), 0.02),
    }


def reference(x, c, ctx, c_ctx, w_ada, b_ada, norm_mix, w_in, conv_w, a_log, dt_bias, gdn_norm,
              attn_sink, w_out, norm_ffn, w_ff1, w_ff2, norm_final):
    L = x.shape[1]
    cos, sin = axial_rope_tables(L, x.dtype)
    silu_c = jax.nn.silu(c)
    silu_cc = jax.nn.silu(c_ctx)
    xl, xc = x, ctx
    for i in range(DEPTH):
        last = i == DEPTH - 1
        mod_l = (silu_c @ w_ada[i] + b_ada[i])[:, None, :]
        mod_c = silu_cc @ w_ada[i] + b_ada[i]
        shm_l, scm_l, gm_l, shf_l, scf_l, gf_l = jnp.split(mod_l, 6, axis=-1)
        shm_c, scm_c, gm_c, shf_c, scf_c, gf_c = jnp.split(mod_c, 6, axis=-1)
        hl = modulate(rmsnorm(xl, norm_mix[i]), shm_l, scm_l)
        hc = modulate(rmsnorm(xc, norm_mix[i]), shm_c, scm_c)
        out_c, out_l = mixer(hc, hl, w_in[i], conv_w[i], a_log[i], dt_bias[i], gdn_norm[i],
                             attn_sink[i], w_out[i], cos, sin, last)
        xl = xl + gm_l * out_l
        xl = xl + gf_l * squared_relu_mlp(modulate(rmsnorm(xl, norm_ffn[i]), shf_l, scf_l), w_ff1[i], w_ff2[i])
        if not last:
            xc = xc + gm_c * out_c
            xc = xc + gf_c * squared_relu_mlp(modulate(rmsnorm(xc, norm_ffn[i]), shf_c, scf_c),
                                              w_ff1[i], w_ff2[i])
    return rmsnorm(xl, norm_final)
```

```cpp
#include <hip/hip_runtime.h>
#include <cstdio>
#include <cstdint>
#include <utility>

constexpr int DM = 2048, NB = 4, SEQ = 2048, DEPTH = 4, CTXL = 256, DH = 128;
constexpr int TT = CTXL + SEQ;
constexpr int M = NB * TT;
constexpr int D_IN = 5664, D_INP = 5888, ZP = 5632, DFF = 8192, D6 = 6 * DM;
constexpr int OFF_AQ = 0, OFF_AK = 1024, OFF_AV = 1280, OFF_GQKV = 1536, OFF_GATE = 4608;
constexpr float EPS = 1e-6f;

constexpr size_t MiB = 1u << 20;
constexpr size_t WS_CTL = 0, CTL_ZERO_BYTES = 1 * MiB;
constexpr size_t WS_MOD = 1 * MiB;
constexpr size_t WS_ROPE = 2 * MiB;
constexpr size_t WS_WIN = 4 * MiB;
constexpr size_t WS_WOUT = 96 * MiB;
constexpr size_t WS_W1 = 128 * MiB;
constexpr size_t WS_W2 = 256 * MiB;
constexpr size_t WS_X = 384 * MiB;
constexpr size_t WS_H = 456 * MiB;
constexpr size_t WS_Z = 492 * MiB;
constexpr size_t WS_AB = 596 * MiB;
constexpr size_t WS_MIX = 598 * MiB;
constexpr size_t WS_FFH = 634 * MiB;
constexpr size_t WS_GQ = 778 * MiB;
constexpr size_t WS_GK = 814 * MiB;
constexpr size_t WS_GV = 850 * MiB;
constexpr size_t WS_GG = 886 * MiB;
constexpr size_t WS_GB = 887 * MiB;
constexpr size_t WS_GO = 888 * MiB;
constexpr size_t WS_AQ = 960 * MiB;
constexpr size_t WS_AK = 996 * MiB;
constexpr size_t WS_GREC = 1008 * MiB;
constexpr size_t WS_GU = 1134 * MiB;
constexpr size_t WS_GL = 1206 * MiB;
constexpr size_t WS_GO2 = 1208 * MiB;
constexpr size_t WS_SLAB = 1280 * MiB;
constexpr size_t WS_ZERO = 1344 * MiB;
constexpr size_t WS_END = 1346 * MiB;

constexpr int NWAVES = 8, NTHREADS = 512;
constexpr int RING_OFF = 0, RING_BYTES = 147456, LDSCTL_OFF = RING_BYTES, MISC_OFF = LDSCTL_OFF + 320;
constexpr int LDS_BYTES = RING_BYTES + 2048;

#define GAS __attribute__((address_space(1)))
#define LAS __attribute__((address_space(3)))
typedef unsigned short bf16;
typedef unsigned v4u __attribute__((ext_vector_type(4)));
typedef unsigned v2u __attribute__((ext_vector_type(2)));
typedef float f32x4 __attribute__((ext_vector_type(4)));
#define LDS_WAIT() asm volatile("s_waitcnt lgkmcnt(0)" ::: "memory")
#define VM_WAIT() asm volatile("s_waitcnt vmcnt(0)" ::: "memory")
#define LDS_BARRIER() asm volatile("s_waitcnt lgkmcnt(0)\n\ts_barrier" ::: "memory")
__device__ __forceinline__ unsigned f2bf(float f) { unsigned u = __builtin_bit_cast(unsigned, f); return (u + 0x7fffu + ((u >> 16) & 1u)) >> 16; }
typedef __bf16 bf16x2p __attribute__((ext_vector_type(2)));
typedef float f32x2p __attribute__((ext_vector_type(2)));
__device__ __forceinline__ unsigned pk2(float lo, float hi) { return __builtin_bit_cast(unsigned, __builtin_convertvector((f32x2p){lo, hi}, bf16x2p)); }
__device__ __forceinline__ float bf2f(unsigned short b) { return __builtin_bit_cast(float, (unsigned)b << 16); }
__device__ __forceinline__ float bflo(unsigned w) { return __builtin_bit_cast(float, w << 16); }
__device__ __forceinline__ float bfhi(unsigned w) { return __builtin_bit_cast(float, w & 0xffff0000u); }
__device__ __forceinline__ float shx(float v, int m, int lane) { return __builtin_bit_cast(float, __builtin_amdgcn_ds_bpermute((lane ^ m) << 2, __builtin_bit_cast(int, v))); }
__device__ __forceinline__ float wave_sum(float v, int lane) {
#pragma unroll
    for (int o = 1; o < 64; o <<= 1) v += shx(v, o, lane);
    return v;
}
__device__ __forceinline__ float siluf(float v) { return v / (1.f + __expf(-v)); }

namespace pg8 {
#define PG8_LAS __attribute__((address_space(3)))
typedef unsigned short bf16_t;
typedef short bf16x8 __attribute__((ext_vector_type(8)));
typedef float f32x4 __attribute__((ext_vector_type(4)));
typedef unsigned u32x4 __attribute__((ext_vector_type(4)));
constexpr int BM = 256, BK = 64, HALF = 128, HTB = HALF * BK * 2  , STAGE_BYTES = 8 * HTB, NXCD = 8, WGM = 8;

__host__ __device__ __forceinline__ int lds_byte(int r, int c) { const int st = (r >> 4) * 2 + (c >> 5), rr = r & 15, cc = c & 31, ob = rr * 64 + cc * 2; return st * 1024 + (ob ^ (((ob >> 9) & 1) << 5)); }
__host__ __device__ __forceinline__ void stage_rc(int b, int& R, int& C) { const int st = b / 1024, sb = b % 1024, swz = sb ^ (((sb >> 9) & 1) << 5); R = (st >> 1) * 16 + swz / 64; C = (st & 1) * 32 + (swz % 64) / 2; }
__host__ __device__ __forceinline__ int perm32(int rho) { const int n = rho >> 4, i = rho & 15; return 8 * (i >> 2) + 4 * n + (i & 3); }

struct Unit { int pm, pn, kofs, nt; };
struct Gemm { const bf16_t* A; const bf16_t* Bt; int M, N, K; };

struct StaticOrder {
    int nM, nN, nwg, G, c;
    __host__ __device__ void init(int M, int N, int G_, int c_) { nM = M / BM; nN = N / BM; nwg = nM * nN; G = G_; c = c_; }
    __host__ __device__ bool next(int i, Unit& u) const {
        const long L = (long)i * G + c; if (L >= nwg) return false;
        int wgid = (int)L; { const int q = nwg / NXCD, r = nwg % NXCD, xcd = wgid % NXCD, off = wgid / NXCD; wgid = (xcd < r ? xcd * (q + 1) : r * (q + 1) + (xcd - r) * q) + off; }
        const int nig = WGM * nN, gid = wgid / nig, fm = gid * WGM, gsz = (nM - fm) < WGM ? (nM - fm) : WGM;
        u.pm = fm + ((wgid % nig) % gsz); u.pn = (wgid % nig) / gsz; return true;
    }
    __device__ __forceinline__ void a_ready(const Unit&) const {}
    __device__ __forceinline__ void done(const Unit&) const {}
};

typedef __bf16 bf16x2c __attribute__((ext_vector_type(2)));
typedef float f32x2c __attribute__((ext_vector_type(2)));
__device__ __forceinline__ unsigned cvt_pk_bf16(float lo, float hi) { return __builtin_bit_cast(unsigned, __builtin_convertvector((f32x2c){lo, hi}, bf16x2c)); }
typedef float f32x2 __attribute__((ext_vector_type(2)));

typedef unsigned u32x4 __attribute__((ext_vector_type(4)));
struct PanelOrder : StaticOrder {
    int skip_ctx, ntk, ksplit, nfull, nMall, consttile = 0;
    __device__ void init2(int nMc, int N, int K, int G_, int c_, int skip, int ksplit_) { nN = N / BM; G = G_; c = c_; skip_ctx = skip; ntk = K / BK; ksplit = ksplit_; nMall = nMc;
        nfull = (ksplit_ > 1) ? ((nMc * nN) / G_) * G_ : nMc * nN; nM = nfull / nN; nwg = nfull; }
    __device__ bool next(int i, Unit& u) const {
        const long L = (long)i * G + c;
        if (L < nfull) { if (!StaticOrder::next(i, u)) return false; u.nt = ntk; u.kofs = 0; }
        else { const long s = L - nfull; const int t = (int)(s / ksplit), ks = (int)(s % ksplit); u.pm = nM + t / nN; u.pn = t % nN; if (u.pm >= nMall) return false;
            u.nt = ntk / ksplit; u.kofs = ks * u.nt * (BK * 2); }
        if (skip_ctx) u.pm = u.pm + (u.pm >> 3) + 1;
        if (consttile) { u.pm = 1; u.pn = 0; }
        return true;
    }
};

struct Gemm1Order {
    int G, c, mode;
    __device__ void init(int G_, int c_, int mode_) { G = G_; c = c_; mode = mode_; }
    __device__ bool next(int i, Unit& u) const {
        u.nt = 32; u.kofs = 0;
        if (mode == 1) { if (i != 0 || c < 0 || c >= 60) return false; u.pm = 21 + (c >> 2); u.pn = 18 + (c & 3); return true; }
        const int L = i * G + c;
        if (L < 684) {
            constexpr int nM = 36, nN = 19, nwg = nM * nN;
            int wgid = L; { const int q = nwg / NXCD, r = nwg % NXCD, xcd = wgid % NXCD, off = wgid / NXCD; wgid = (xcd < r ? xcd * (q + 1) : r * (q + 1) + (xcd - r) * q) + off; }
            const int nig = WGM * nN, gid = wgid / nig, fm = gid * WGM, gsz = (nM - fm) < WGM ? (nM - fm) : WGM;
            u.pm = fm + ((wgid % nig) % gsz); const int pn = (wgid % nig) / gsz; u.pn = pn < 18 ? pn : 22; return true; }
        if (L < 768) { const int idx = L - 684; u.pm = idx >> 2; u.pn = 18 + (idx & 3); return true; }
        return false;
    }
    __device__ __forceinline__ void a_ready(const Unit&) const {}
    __device__ __forceinline__ void done(const Unit&) const {}
};

struct EpiZ {
    static constexpr bool PERM = true, AFTER_DRAIN = false;
    bf16_t* Z; float* AB; const float* rope;
    __device__ __forceinline__ void operator()(const f32x4 (&acc)[2][2][4][2], const Unit& u, int wr, int wc, int fr, int fq) const {
        const int row0 = u.pm * BM + wr * 64 + fr;
        if (u.pn == 22) {
            if (wc == 0) {
#pragma unroll
                for (int ai = 0; ai < 2; ++ai)
#pragma unroll
                    for (int m = 0; m < 4; ++m) { float* rp = AB + (size_t)(row0 + ai * HALF + m * 16) * 32 + 8 * fq;
                        *(f32x4*)(rp) = acc[ai][0][m][0]; *(f32x4*)(rp + 4) = acc[ai][0][m][1]; }
            }
        } else {
            const int col0 = u.pn * BM + wc * 32 + 8 * fq;
            const int pb = u.pm / 9; const bool dorope = (u.pn < 5) && (u.pm - 9 * pb != 0);
            const int tl0 = (u.pm - 9 * pb - 1) * BM + wr * 64 + fr;
#pragma unroll
            for (int ai = 0; ai < 2; ++ai) {
                f32x4 csv[4], snv[4];
                if (dorope) {
#pragma unroll
                    for (int m = 0; m < 4; ++m) { const int tl = tl0 + ai * HALF + m * 16, c = col0, half = (c >> 6) & 1, i0 = (c & 63) >> 1, pe = half ? 32 + (tl & 63) : (tl >> 6);
                        csv[m] = *(const f32x4*)(rope + pe * 32 + i0); snv[m] = *(const f32x4*)(rope + 96 * 32 + pe * 32 + i0); }
                    __builtin_amdgcn_sched_barrier(0); }
#pragma unroll
                for (int m = 0; m < 4; ++m) { bf16_t* rowp = Z + (size_t)(row0 + ai * HALF + m * 16) * 5632 + col0;
#pragma unroll
                    for (int bj = 0; bj < 2; ++bj) { f32x4 v0 = acc[ai][bj][m][0], v1 = acc[ai][bj][m][1];
                        if (dorope) { const f32x4 cs = csv[m], sn = snv[m];
                            const f32x4 a0 = v0, a1 = v1;
                            v0[0] = a0[0] * cs[0] - a0[1] * sn[0]; v0[1] = a0[1] * cs[0] + a0[0] * sn[0];
                            v0[2] = a0[2] * cs[1] - a0[3] * sn[1]; v0[3] = a0[3] * cs[1] + a0[2] * sn[1];
                            v1[0] = a1[0] * cs[2] - a1[1] * sn[2]; v1[1] = a1[1] * cs[2] + a1[0] * sn[2];
                            v1[2] = a1[2] * cs[3] - a1[3] * sn[3]; v1[3] = a1[3] * cs[3] + a1[2] * sn[3]; }
                        u32x4 w; w.x = cvt_pk_bf16(v0[0], v0[1]); w.y = cvt_pk_bf16(v0[2], v0[3]); w.z = cvt_pk_bf16(v1[0], v1[1]); w.w = cvt_pk_bf16(v1[2], v1[3]);
                        *(u32x4*)(rowp + bj * HALF) = w; } } }
        }
    }
};
struct EpiSq {
    static constexpr bool PERM = true, AFTER_DRAIN = false;
    bf16_t* O; int ldc;
    __device__ __forceinline__ void operator()(const f32x4 (&acc)[2][2][4][2], const Unit& u, int wr, int wc, int fr, int fq) const {
        const int row0 = u.pm * BM + wr * 64 + fr, col0 = u.pn * BM + wc * 32 + 8 * fq;
#pragma unroll
        for (int ai = 0; ai < 2; ++ai)
#pragma unroll
            for (int m = 0; m < 4; ++m) { bf16_t* rowp = O + (size_t)(row0 + ai * HALF + m * 16) * ldc + col0;
#pragma unroll
                for (int bj = 0; bj < 2; ++bj) { f32x4 v0 = acc[ai][bj][m][0], v1 = acc[ai][bj][m][1];
#pragma unroll
                    for (int j = 0; j < 4; ++j) { const float a = fmaxf(v0[j], 0.f), b = fmaxf(v1[j], 0.f); v0[j] = a * a; v1[j] = b * b; }
                    u32x4 w; w.x = cvt_pk_bf16(v0[0], v0[1]); w.y = cvt_pk_bf16(v0[2], v0[3]); w.z = cvt_pk_bf16(v1[0], v1[1]); w.w = cvt_pk_bf16(v1[2], v1[3]);
                    *(u32x4*)(rowp + bj * HALF) = w; } }
    }
};
struct EpiGate {
    static constexpr bool PERM = false, AFTER_DRAIN = false;
    float* X; const float* modl; int goff, ntfull; float* slab;
    __device__ __forceinline__ void operator()(const f32x4 (&acc)[2][2][4][2], const Unit& u, int wr, int wc, int fr, int fq) const {
        const int row0 = u.pm * BM + wr * 64 + fr, col0 = u.pn * BM + wc * 32 + 4 * fq;
        if (u.nt != ntfull) {
            const int ks = u.kofs / (u.nt * (BK * 2));
            float* base = slab + ((size_t)ks * 1024 + (row0 - 8192)) * 2048 + col0;
#pragma unroll
            for (int ai = 0; ai < 2; ++ai)
#pragma unroll
                for (int m = 0; m < 4; ++m) { float* rowp = base + (size_t)(ai * HALF + m * 16) * 2048;
#pragma unroll
                    for (int bj = 0; bj < 2; ++bj)
#pragma unroll
                        for (int n = 0; n < 2; ++n) *(f32x4*)(rowp + bj * HALF + n * 16) = acc[ai][bj][m][n]; }
            return;
        }
        const int b = u.pm / 9, r = (u.pm - 9 * b == 0) ? 4 : b;
        const float* gate = modl + (size_t)r * 12288 + goff;
        f32x4 gv[2][2];
#pragma unroll
        for (int bj = 0; bj < 2; ++bj)
#pragma unroll
            for (int n = 0; n < 2; ++n) gv[bj][n] = *(const f32x4*)(gate + col0 + bj * HALF + n * 16);
#pragma unroll
        for (int ai = 0; ai < 2; ++ai)
#pragma unroll
            for (int mp = 0; mp < 2; ++mp) { float* rowp = X + (size_t)(row0 + ai * HALF + mp * 32) * 2048 + col0;
                f32x4 xv[2][2][2];
#pragma unroll
                for (int mm = 0; mm < 2; ++mm)
#pragma unroll
                    for (int bj = 0; bj < 2; ++bj)
#pragma unroll
                        for (int n = 0; n < 2; ++n) xv[mm][bj][n] = *(const f32x4*)(rowp + (size_t)mm * 16 * 2048 + bj * HALF + n * 16);
                __builtin_amdgcn_sched_barrier(0);
#pragma unroll
                for (int mm = 0; mm < 2; ++mm)
#pragma unroll
                    for (int bj = 0; bj < 2; ++bj)
#pragma unroll
                        for (int n = 0; n < 2; ++n) *(f32x4*)(rowp + (size_t)mm * 16 * 2048 + bj * HALF + n * 16) = xv[mm][bj][n] + gv[bj][n] * acc[ai][bj][2 * mp + mm][n];
                __builtin_amdgcn_sched_barrier(0); }
    }
};

template <class Epi, class Sched, bool ALIGN_EPI = false, bool SP2 = false>
__device__ __forceinline__ void gemm_phase(PG8_LAS unsigned char* lds, const Gemm g, const Sched& S, const Epi& E, const int tid_l) {
    const int tid = tid_l, wid = __builtin_amdgcn_readfirstlane(tid >> 6), lane = tid & 63, wr = wid >> 2, wc = wid & 3, fr = lane & 15, fq = lane >> 4;
    const int K = g.K;
    unsigned voffA[2], voffB[2];
#pragma unroll
    for (int i = 0; i < 2; ++i) { int R, C; stage_rc(tid * 16 + i * 8192, R, C); const int Rb = Epi::PERM ? ((R & ~31) + perm32(R & 31)) : R;
        voffA[i] = (unsigned)(R * K + C) * 2u; voffB[i] = (unsigned)(Rb * K + C) * 2u; }
    const size_t kstep = (size_t)(BK * 2);
    const size_t hstep = (size_t)HALF * K * 2;
    const size_t tstep = 2 * hstep;
    const unsigned ldsw = (unsigned)wid * 1024u;
    const int aoff = lds_byte(wr * 64 + fr, fq * 8), boff = lds_byte(wc * 32 + fr, fq * 8);
#define PG8_SA(b, h) (((b) * 2 + (h)) * HTB)
#define PG8_SB(b, h) ((4 + (b) * 2 + (h)) * HTB)
#define PG8_STAGE(bufoff, gbase, voff) do { const char* _gb = (const char*)(gbase); asm volatile("" : "+s"(_gb)); _Pragma("unroll") for (int _i = 0; _i < 2; ++_i) { \
        unsigned _vo = (voff)[_i]; asm volatile("" : "+v"(_vo)); \
        __builtin_amdgcn_global_load_lds((const unsigned*)(_gb + _vo), (PG8_LAS unsigned*)(lds + (bufoff) + ldsw + _i * 8192), 16, 0, 0); } } while (0)
#define PG8_LDA(dst, b, h) do { _Pragma("unroll") for (int m = 0; m < 4; ++m) _Pragma("unroll") for (int k = 0; k < 2; ++k) dst[m][k] = *(const PG8_LAS bf16x8*)(lds + PG8_SA(b, h) + aoff + m * 2048 + k * 1024); } while (0)
#define PG8_LDB(dst, b, h) do { _Pragma("unroll") for (int n = 0; n < 2; ++n) _Pragma("unroll") for (int k = 0; k < 2; ++k) dst[n][k] = *(const PG8_LAS bf16x8*)(lds + PG8_SB(b, h) + boff + n * 2048 + k * 1024); } while (0)
#define PG8_MMA(ai, bj, At, Bt) do { __builtin_amdgcn_s_setprio(1); _Pragma("unroll") for (int m = 0; m < 4; ++m) _Pragma("unroll") for (int n = 0; n < 2; ++n) _Pragma("unroll") for (int k = 0; k < 2; ++k) \
        acc[ai][bj][m][n] = __builtin_amdgcn_mfma_f32_16x16x32_bf16(Bt[n][k], At[m][k], acc[ai][bj][m][n], 0, 0, 0); __builtin_amdgcn_s_setprio(0); } while (0)
#define PG8_WAIT_V(n) asm volatile("s_waitcnt vmcnt(" #n ")" ::: "memory")
#define PG8_WAIT_L(n) asm volatile("s_waitcnt lgkmcnt(" #n ")" ::: "memory")
#define PG8_BAR __builtin_amdgcn_s_barrier()
#define PG8_SCHED __builtin_amdgcn_sched_barrier(0)
    Unit cur, nxt; int ui = 0;
    if (!S.next(0, cur)) return;
    f32x4 acc[2][2][4][2];
#pragma unroll
    for (int a = 0; a < 2; ++a)
#pragma unroll
        for (int b = 0; b < 2; ++b)
#pragma unroll
            for (int m = 0; m < 4; ++m)
#pragma unroll
                for (int n = 0; n < 2; ++n) acc[a][b][m][n] = (f32x4){0.f, 0.f, 0.f, 0.f};
    bf16x8 At[4][2], B0[2][2], B1[2][2];
    const char* cA = (const char*)g.A + (size_t)cur.pm * tstep + cur.kofs; const char* cB = (const char*)g.Bt + (size_t)cur.pn * tstep + cur.kofs;
    S.a_ready(cur);
    if constexpr (SP2) {
        PG8_STAGE(PG8_SB(0, 0), cB, voffB); PG8_STAGE(PG8_SB(0, 1), cB + hstep, voffB); PG8_STAGE(PG8_SA(0, 0), cA, voffA); PG8_STAGE(PG8_SA(0, 1), cA + hstep, voffA);
        if (wr == 1) PG8_BAR;
        PG8_WAIT_V(2); PG8_BAR;
        PG8_STAGE(PG8_SB(1, 0), cB + kstep, voffB); PG8_STAGE(PG8_SA(1, 0), cA + kstep, voffA); PG8_STAGE(PG8_SB(1, 1), cB + hstep + kstep, voffB);
        PG8_WAIT_V(6); PG8_BAR;
    } else {
        PG8_STAGE(PG8_SB(0, 0), cB, voffB); PG8_STAGE(PG8_SA(0, 0), cA, voffA); PG8_STAGE(PG8_SB(0, 1), cB + hstep, voffB); PG8_STAGE(PG8_SA(0, 1), cA + hstep, voffA);
        if (wr == 1) PG8_BAR;
        PG8_WAIT_V(4); PG8_BAR;
        PG8_STAGE(PG8_SB(1, 0), cB + kstep, voffB); PG8_STAGE(PG8_SA(1, 0), cA + kstep, voffA); PG8_STAGE(PG8_SB(1, 1), cB + hstep + kstep, voffB);
        PG8_WAIT_V(6); PG8_BAR;
    }
    for (;;) {
        const bool has_next = S.next(ui + 1, nxt);
        const char* nA = has_next ? (const char*)g.A + (size_t)nxt.pm * tstep + nxt.kofs : cA; const char* nB = has_next ? (const char*)g.Bt + (size_t)nxt.pn * tstep + nxt.kofs : cB;
        const int nt = cur.nt;
        for (int t = 0; t < nt; t += 2) {
            const bool last = (t == nt - 2);
            const char* a1 = cA + (size_t)(t + 1) * kstep;
            const char* a2 = last ? nA : cA + (size_t)(t + 2) * kstep; const char* b2 = last ? nB : cB + (size_t)(t + 2) * kstep;
            const char* a3 = a2 + kstep; const char* b3 = b2 + kstep;
            if (last && has_next) S.a_ready(nxt);
            if constexpr (SP2) {
            PG8_LDB(B0, 0, 0); PG8_LDB(B1, 0, 1); PG8_SCHED; PG8_LDA(At, 0, 0); PG8_STAGE(PG8_SA(1, 1), a1 + hstep, voffA);
            PG8_WAIT_V(8); PG8_WAIT_L(0); PG8_BAR; PG8_MMA(0, 0, At, B0); PG8_MMA(0, 1, At, B1); PG8_BAR; PG8_SCHED;
            PG8_LDA(At, 0, 1); PG8_STAGE(PG8_SB(0, 0), b2, voffB); PG8_STAGE(PG8_SB(0, 1), b2 + hstep, voffB); PG8_STAGE(PG8_SA(0, 0), a2, voffA);
            PG8_WAIT_V(8); PG8_WAIT_L(0); PG8_BAR; PG8_MMA(1, 0, At, B0); PG8_MMA(1, 1, At, B1); PG8_BAR; PG8_SCHED;
            PG8_LDB(B0, 1, 0); PG8_LDB(B1, 1, 1); PG8_SCHED; PG8_LDA(At, 1, 0); PG8_STAGE(PG8_SA(0, 1), a2 + hstep, voffA);
            PG8_WAIT_V(8); PG8_WAIT_L(0); PG8_BAR; PG8_MMA(0, 0, At, B0); PG8_MMA(0, 1, At, B1); PG8_BAR; PG8_SCHED;
            PG8_LDA(At, 1, 1); PG8_STAGE(PG8_SB(1, 0), b3, voffB); PG8_STAGE(PG8_SB(1, 1), b3 + hstep, voffB); PG8_STAGE(PG8_SA(1, 0), a3, voffA);
            PG8_WAIT_V(8); PG8_WAIT_L(0); PG8_BAR; PG8_MMA(1, 0, At, B0); PG8_MMA(1, 1, At, B1); PG8_BAR; PG8_SCHED;
            } else {
            PG8_LDB(B0, 0, 0); PG8_SCHED; PG8_LDA(At, 0, 0); PG8_STAGE(PG8_SA(1, 1), a1 + hstep, voffA);
            PG8_WAIT_L(8); PG8_BAR; PG8_WAIT_L(0); PG8_MMA(0, 0, At, B0); PG8_BAR; PG8_SCHED;
            PG8_LDB(B1, 0, 1); PG8_STAGE(PG8_SB(0, 0), b2, voffB);
            PG8_BAR; PG8_WAIT_L(0); PG8_MMA(0, 1, At, B1); PG8_BAR;
            PG8_LDA(At, 0, 1); PG8_STAGE(PG8_SA(0, 0), a2, voffA);
            PG8_BAR; PG8_WAIT_L(0); PG8_MMA(1, 0, At, B0); PG8_BAR; PG8_SCHED;
            PG8_STAGE(PG8_SB(0, 1), b2 + hstep, voffB);
            PG8_WAIT_V(6); PG8_BAR; PG8_MMA(1, 1, At, B1); PG8_BAR;
            PG8_LDB(B0, 1, 0); PG8_SCHED; PG8_LDA(At, 1, 0); PG8_STAGE(PG8_SA(0, 1), a2 + hstep, voffA);
            PG8_WAIT_L(8); PG8_BAR; PG8_WAIT_L(0); PG8_MMA(0, 0, At, B0); PG8_BAR; PG8_SCHED;
            PG8_LDB(B1, 1, 1); PG8_STAGE(PG8_SB(1, 0), b3, voffB);
            PG8_BAR; PG8_WAIT_L(0); PG8_MMA(0, 1, At, B1); PG8_BAR;
            PG8_LDA(At, 1, 1); PG8_STAGE(PG8_SA(1, 0), a3, voffA);
            PG8_BAR; PG8_WAIT_L(0); PG8_MMA(1, 0, At, B0); PG8_BAR; PG8_SCHED;
            PG8_STAGE(PG8_SB(1, 1), b3 + hstep, voffB);
            PG8_WAIT_V(6); PG8_BAR; PG8_MMA(1, 1, At, B1); PG8_BAR;
            }
        }
        if constexpr (ALIGN_EPI) { if (wr == 0) PG8_BAR; }
        if constexpr (!Epi::AFTER_DRAIN) { int frl = fr, fql = fq; asm volatile("" : "+v"(frl), "+v"(fql));
            E(acc, cur, wr, wc, frl, fql); S.done(cur); }
        if (!has_next) break;
#pragma unroll
        for (int a = 0; a < 2; ++a)
#pragma unroll
            for (int b = 0; b < 2; ++b)
#pragma unroll
                for (int m = 0; m < 4; ++m)
#pragma unroll
                    for (int n = 0; n < 2; ++n) acc[a][b][m][n] = (f32x4){0.f, 0.f, 0.f, 0.f};
        cur = nxt; cA = nA; cB = nB; ++ui;
        if constexpr (ALIGN_EPI) { if (wr == 1) PG8_BAR; }
    }
    PG8_WAIT_V(0);
    if constexpr (!ALIGN_EPI) { if (wr == 0) PG8_BAR; }
    PG8_BAR;
    if constexpr (Epi::AFTER_DRAIN) { E.fused(acc, cur, wr, wc, fr, fq, lds, wid, lane); S.done(cur); }
#undef PG8_SA
#undef PG8_SB
#undef PG8_STAGE
#undef PG8_LDA
#undef PG8_LDB
#undef PG8_MMA
#undef PG8_WAIT_V
#undef PG8_WAIT_L
#undef PG8_BAR
#undef PG8_SCHED
}
}

#define XB_TMO      128
#define XB_XCNT(j)  (256  + 64 * (j))
#define XB_XSUB(j)  (1280 + 64 * (j))
#define XB_XGEN(j)  (2304 + 64 * (j))
#define XB_TOP      3328
#define XB_TOPGEN   3392
#define XCD_BAR_WORDS 3456
#define XB_SPIN_CAP (1u << 18)

__device__ __forceinline__ unsigned xb_ld(unsigned* p)              { return __hip_atomic_load(p, __ATOMIC_RELAXED, __HIP_MEMORY_SCOPE_AGENT); }
__device__ __forceinline__ unsigned xb_add(unsigned* p, unsigned v) { return __hip_atomic_fetch_add(p, v, __ATOMIC_RELAXED, __HIP_MEMORY_SCOPE_AGENT); }
__device__ __forceinline__ unsigned xb_xcc_id() { return (unsigned)__builtin_amdgcn_s_getreg((3 << 11) | 20) & 0xFu; }
#define XB_SPIN(cond, bar) do { unsigned _sp = 0; while (cond) { __builtin_amdgcn_s_sleep(1); \
    if ((++_sp & 255u) == 0u) { if (xb_ld(&(bar)[XB_TMO])) break; if (_sp > XB_SPIN_CAP) { atomicAdd(&(bar)[XB_TMO], 1u); break; } } } } while (0)

struct XcdBarrier {
    unsigned* bar; unsigned x;
    volatile LAS unsigned* st;
};

__device__ __forceinline__ XcdBarrier xcd_barrier_post(unsigned* bar, volatile LAS unsigned* st) {
    XcdBarrier b; b.bar = bar; b.x = xb_xcc_id(); b.st = st;
    if (threadIdx.x == 0) (void)xb_add(&bar[XB_XCNT(b.x)], 1u);
    return b;
}
__device__ __forceinline__ void xcd_barrier_complete(unsigned* bar, unsigned x, unsigned& nloc, unsigned& nx) {
    const unsigned G = gridDim.x * gridDim.y * gridDim.z;
    unsigned sum, cnt, mine, sp = 0u;
    for (;;) {
        sum = 0u; cnt = 0u; mine = 0u;
#pragma unroll 1
        for (unsigned j = 0; j < 16; ++j) { const unsigned c = xb_ld(&bar[XB_XCNT(j)]); sum += c; cnt += (c > 0u) ? 1u : 0u; mine = (j == x) ? c : mine; }
        if (sum == G) break;
        __builtin_amdgcn_s_sleep(1);
        if ((++sp & 255u) == 0u) { if (xb_ld(&bar[XB_TMO])) break; if (sp > XB_SPIN_CAP) { atomicAdd(&bar[XB_TMO], 1u); break; } }
    }
    nloc = mine > 0u ? mine : 1u; nx = cnt > 0u ? cnt : 1u;
}

__device__ __forceinline__ void xcd_barrier(const XcdBarrier& b) {
    asm volatile("s_waitcnt vmcnt(0)" ::: "memory");
    __syncthreads();
    if (threadIdx.x == 0) {
        __attribute__((address_space(1))) unsigned* bar_g = (__attribute__((address_space(1))) unsigned*)b.bar; asm volatile("" : "+s"(bar_g)); unsigned* bar = (unsigned*)bar_g;
        __builtin_amdgcn_s_waitcnt(0);
        unsigned nloc = b.st[0], nx = b.st[1];
        if (nloc == 0u) { xcd_barrier_complete(bar, b.x, nloc, nx); b.st[0] = nloc; b.st[1] = nx; }
        const unsigned old = xb_add(&bar[XB_XSUB(b.x)], 1u);
        const unsigned gen = old / nloc;
        if (old + 1u == (gen + 1u) * nloc) {
            __builtin_amdgcn_fence(__ATOMIC_RELEASE, "agent");
            asm volatile("s_waitcnt vmcnt(0)" ::: "memory");
            const unsigned og = xb_add(&bar[XB_TOP], 1u);
            const unsigned tg = og / nx;
            if (og + 1u == (tg + 1u) * nx) xb_add(&bar[XB_TOPGEN], 1u);
            else XB_SPIN(xb_ld(&bar[XB_TOPGEN]) == tg, bar);
            __builtin_amdgcn_fence(__ATOMIC_ACQUIRE, "agent");
            asm volatile("s_waitcnt vmcnt(0)" ::: "memory");
        } else {
            XB_SPIN(xb_ld(&bar[XB_TOPGEN]) == gen, bar);
            __builtin_amdgcn_fence(__ATOMIC_ACQUIRE, "agent");
            asm volatile("s_waitcnt vmcnt(0)" ::: "memory");
        }
    }
    __syncthreads();
}

struct Args { const float* in[18]; float* out; unsigned char* ws; int gp_lo, gp_hi, bar_region, pad1; };
constexpr int CW_BAR = 4096, N_BAR_REGIONS = 16;
enum { I_X = 0, I_C, I_CTX, I_CCTX, I_WADA, I_BADA, I_NMIX, I_WIN, I_CONVW, I_ALOG, I_DTB, I_GNORM, I_SINK, I_WOUT, I_NFFN, I_W1, I_W2, I_NFINAL };
struct Frame { LAS unsigned char* lds; int tid, lane, wave, vcu, G, bx; };
__device__ __forceinline__ Args relaunder_args(const Args& a) { Args r = a;
#pragma unroll
    for (int i = 0; i < 18; ++i) { const GAS float* p = (const GAS float*)r.in[i]; asm volatile("" : "+s"(p)); r.in[i] = (const float*)p; }
    { GAS float* p = (GAS float*)r.out; asm volatile("" : "+s"(p)); r.out = (float*)p; } { GAS unsigned char* p = (GAS unsigned char*)r.ws; asm volatile("" : "+s"(p)); r.ws = (unsigned char*)p; }
    return r; }
__device__ __forceinline__ Frame relaunder(const Frame& F0) { Frame F = F0; int ln; asm volatile("v_mbcnt_lo_u32_b32 %0, -1, 0\n\tv_mbcnt_hi_u32_b32 %0, -1, %0" : "=v"(ln));
    int w = F0.wave, v = F0.vcu, G = F0.G, bx = F0.bx; asm volatile("" : "+s"(w), "+s"(v), "+s"(G), "+s"(bx));
    F.lane = ln; F.wave = w; F.vcu = v; F.G = G; F.bx = bx; F.tid = w * 64 + ln; return F; }
constexpr int NPH = 9;
__host__ __device__ constexpr int GP(int layer, int p) { return 1 + layer * NPH + p; }
constexpr int GP_FINAL = 1 + DEPTH * NPH;
constexpr int REP_NB = 0, REP_BAR = 1, REP_XC = 1, REP_CT = 0, REP_G1 = 1, REP_G2 = 1, REP_G3 = 1, REP_G4 = 1, REP_PT = 1, REP_PA = 1, REP_PRO = 1, REP_GEMM = 1, REP_MIX = 1, REP_NORM = 1, REP_PREP = 1, REP_SCAN = 1, REP_ATTN = 1, REP_OUT = 1, REP_FIN = 1;

__device__ __forceinline__ void p0_item_load(const float* W, int N, int item, int lane, f32x4 (&wv)[8]) {
    const int nblk = N / 32, kb = item / nblk, nb = item % nblk, k0 = 64 * kb, n0 = 32 * nb;
#pragma unroll
    for (int i = 0; i < 8; ++i) wv[i] = *(const f32x4*)(W + (size_t)(k0 + 8 * i + (lane >> 3)) * N + n0 + 4 * (lane & 7));
}
__device__ __forceinline__ void p0_item_store(const f32x4 (&wv)[8], int K, int N, bf16* WT, LAS float* scr, int item, int lane, int qkperm) {
    const int nblk = N / 32, kb = item / nblk, nb = item % nblk, k0 = 64 * kb, n0 = 32 * nb;
#pragma unroll
    for (int i = 0; i < 8; ++i) { LAS float* d = scr + (8 * i + (lane >> 3)) * 33 + 4 * (lane & 7); d[0] = wv[i].x; d[1] = wv[i].y; d[2] = wv[i].z; d[3] = wv[i].w; }
    LDS_WAIT(); asm volatile("" ::: "memory");
    const int c = lane & 7;
#pragma unroll
    for (int j = 0; j < 4; ++j) { const int n = (lane >> 3) + 8 * j; const LAS float* s = scr + (8 * c) * 33 + n;
        v4u o; o.x = pk2(s[0 * 33], s[1 * 33]); o.y = pk2(s[2 * 33], s[3 * 33]); o.z = pk2(s[4 * 33], s[5 * 33]); o.w = pk2(s[6 * 33], s[7 * 33]);
        int nd = n0 + n; if (nd < qkperm) { const int w = nd & 63; nd = (nd & ~63) + 2 * (w & 31) + (w >> 5); }
        *(v4u*)(WT + (size_t)nd * K + k0 + 8 * c) = o; }
    LDS_WAIT(); asm volatile("" ::: "memory");
}
constexpr int CV_A = (DM / 64) * (D_IN / 32), CV_B = CV_A + (DM / 64) * (DM / 32), CV_C = CV_B + (DM / 64) * (DFF / 32), CV_LAYER = CV_C + (DFF / 64) * (DM / 32);
#ifndef CV_DEFER
#define CV_DEFER 12288
#endif
#ifndef CV_PREP
#define CV_PREP 4096
#endif
#ifndef CV_P3
#define CV_P3 3648
#endif
constexpr int CV_DEF_ALL = CV_DEFER + CV_PREP + CV_P3;
__device__ __forceinline__ void cv_load(const Args& a, int l, int it, int lane, f32x4 (&wv)[8]) {
    if (it < CV_A) p0_item_load(a.in[I_WIN] + (size_t)l * DM * D_IN, D_IN, it, lane, wv);
    else if (it < CV_B) p0_item_load(a.in[I_WOUT] + (size_t)l * DM * DM, DM, it - CV_A, lane, wv);
    else if (it < CV_C) p0_item_load(a.in[I_W1] + (size_t)l * DM * DFF, DFF, it - CV_B, lane, wv);
    else p0_item_load(a.in[I_W2] + (size_t)l * DFF * DM, DM, it - CV_C, lane, wv);
}
__device__ __forceinline__ void cv_store(const Args& a, const f32x4 (&wv)[8], LAS float* scr, int l, int it, int lane) {
    unsigned char* ws = a.ws;
    if (it < CV_A) p0_item_store(wv, DM, D_IN, (bf16*)(ws + WS_WIN) + (size_t)l * D_INP * DM, scr, it, lane, 1280);
    else if (it < CV_B) p0_item_store(wv, DM, DM, (bf16*)(ws + WS_WOUT) + (size_t)l * DM * DM, scr, it - CV_A, lane, 0);
    else if (it < CV_C) p0_item_store(wv, DM, DFF, (bf16*)(ws + WS_W1) + (size_t)l * DFF * DM, scr, it - CV_B, lane, 0);
    else p0_item_store(wv, DFF, DM, (bf16*)(ws + WS_W2) + (size_t)l * DM * DFF, scr, it - CV_C, lane, 0);
}
constexpr int CV_S0 = CV_C - (CV_PREP + CV_P3), CV_NR = CV_S0 + (CV_LAYER - CV_C), CV_RPRO = CV_NR - CV_DEFER;
static_assert(CV_S0 >= CV_B && CV_RPRO >= 0, "conversion split");
__device__ __forceinline__ int cv_ritem(int q) { return q < CV_S0 ? q : q - CV_S0 + CV_C; }
template <int MODE>
__device__ __forceinline__ void cv_jobs(const Frame& F, const Args& a, int lfix, int base, int njobs, int w, int nw) {
    LAS float* scr = (LAS float*)(F.lds + RING_OFF + F.wave * 16384);
    f32x4 sa[8], sb[8];
#define CV_MAP(g_, l_, it_) do { (l_) = lfix; \
        if (MODE == 2) (it_) = CV_S0 + base + (g_); \
        else if (MODE == 1) (it_) = cv_ritem(g_); \
        else if ((g_) < CV_NR) (it_) = cv_ritem(g_); \
        else { const int q_ = ((g_) - CV_NR) / CV_RPRO; (l_) = 1 + q_; (it_) = cv_ritem(CV_DEFER + ((g_) - CV_NR) - q_ * CV_RPRO); } } while (0)
    for (int g = w; g < njobs; g += 2 * nw) {
        const int g1 = g + nw; int l, it, l1, it1; CV_MAP(g, l, it); CV_MAP(g1, l1, it1);
        cv_load(a, l, it, F.lane, sa);
        if (g1 < njobs) cv_load(a, l1, it1, F.lane, sb);
        cv_store(a, sa, scr, l, it, F.lane);
        if (g1 < njobs) cv_store(a, sb, scr, l1, it1, F.lane);
    }
#undef CV_MAP
}
template <int MODE>
__device__ __forceinline__ void cv_deferred(const Frame& F0, const Args& a0, int lfix, int base, int njobs, int w, int nw) {
    const Frame F = relaunder(F0); const Args a = relaunder_args(a0);
    cv_jobs<MODE>(F, a, lfix, base, njobs, w, nw);
}

__device__ __forceinline__ void p0_prologue(const Frame& F0, const Args& a0) {
    const Frame F = relaunder(F0); const Args a = relaunder_args(a0);
    unsigned char* ws = a.ws;
    for (int rep = 0; rep < REP_PT; ++rep) cv_jobs<0>(F, a, 0, 0, CV_NR + (DEPTH - 1) * CV_RPRO, F.vcu * NWAVES + F.wave, F.G * NWAVES);
    const size_t gt = (size_t)F.vcu * NTHREADS + F.tid, GT = (size_t)F.G * NTHREADS;
    { constexpr size_t per = (size_t)(D_INP - D_IN) * DM * 2 / 16;
      for (size_t i = gt; i < per * DEPTH; i += GT) { const size_t l = i / per, r = i % per;
          ((v4u*)((bf16*)(ws + WS_WIN) + ((size_t)l * D_INP + D_IN) * DM))[r] = (v4u){0u, 0u, 0u, 0u}; } }
    { float* rc = (float*)(ws + WS_ROPE); float* rs = rc + 96 * 32;
      for (size_t i = gt; i < 96 * 32; i += GT) { const int p = (int)i / 32, fi = (int)i % 32; const float pos = (float)(p < 32 ? p : p - 32);
          const float invf = powf(10000.0f, -(float)(2 * fi) / 64.0f), ang = pos * invf; rc[i] = cosf(ang); rs[i] = sinf(ang); } }
    {
        LAS float* sc = (LAS float*)(F.lds + RING_OFF); LAS float* red = (LAS float*)(F.lds + RING_OFF + 49152);
        __syncthreads();
        for (int i = F.tid; i < 5 * DM; i += NTHREADS) { const int r = i / DM, k = i % DM; const float v = (r < 4) ? a.in[I_C][r * DM + k] : a.in[I_CCTX][k]; sc[i] = v / (1.f + expf(-v)); }
        __syncthreads();
        float* MOD = (float*)(ws + WS_MOD);
        for (int rpa = 0; rpa < REP_PA; ++rpa)
        for (int unit = F.vcu; unit < DEPTH * (D6 / 64); unit += F.G) {
            const int l = unit / (D6 / 64), n0 = (unit % (D6 / 64)) * 64, kp = F.lane >> 4, nq = F.lane & 15;
            const float* w = a.in[I_WADA] + ((size_t)l * DM + F.wave * 256 + kp) * D6 + n0 + 4 * nq;
            const LAS float* s = sc + F.wave * 256 + kp;
            f32x4 a0 = (f32x4){0.f, 0.f, 0.f, 0.f}, a1 = a0, a2 = a0, a3 = a0, a4 = a0;
#pragma unroll 8
            for (int k = 0; k < 64; ++k) { const f32x4 wv = *(const f32x4*)(w + (size_t)(4 * k) * D6); a0 += wv * s[4 * k]; a1 += wv * s[DM + 4 * k]; a2 += wv * s[2 * DM + 4 * k]; a3 += wv * s[3 * DM + 4 * k]; a4 += wv * s[4 * DM + 4 * k]; }
#pragma unroll
            for (int e = 0; e < 4; ++e) { a0[e] += shx(a0[e], 32, F.lane); a1[e] += shx(a1[e], 32, F.lane); a2[e] += shx(a2[e], 32, F.lane); a3[e] += shx(a3[e], 32, F.lane); a4[e] += shx(a4[e], 32, F.lane);
                a0[e] += shx(a0[e], 16, F.lane); a1[e] += shx(a1[e], 16, F.lane); a2[e] += shx(a2[e], 16, F.lane); a3[e] += shx(a3[e], 16, F.lane); a4[e] += shx(a4[e], 16, F.lane); }
            if (kp == 0) { LAS f32x4* r4 = (LAS f32x4*)red + (F.wave * 5) * 16 + nq; r4[0] = a0; r4[16] = a1; r4[32] = a2; r4[48] = a3; r4[64] = a4; }
            __syncthreads();
            for (int o = F.tid; o < 5 * 64; o += NTHREADS) { const int r = o / 64, cl = o % 64; float sum = 0.f;
#pragma unroll
                for (int wv = 0; wv < 8; ++wv) sum += red[(wv * 5 + r) * 64 + cl];
                MOD[((size_t)l * 5 + r) * D6 + n0 + cl] = sum + a.in[I_BADA][(size_t)l * D6 + n0 + cl]; }
            __syncthreads();
        }
    }
}

__device__ __forceinline__ void norm_mod_phase(const Frame& F0, const Args& a0, int l, int which, bool skip_ctx, const float* slabgate) {
    const Frame F = relaunder(F0); const Args a = relaunder_args(a0);
    const float* X = (const float*)(a.ws + WS_X); bf16* H = (bf16*)(a.ws + WS_H);
    const float* gain = a.in[which ? I_NFFN : I_NMIX] + (size_t)l * DM;
    const float* modl = (const float*)(a.ws + WS_MOD) + (size_t)l * 5 * D6;
    const int gw = F.vcu * NWAVES + F.wave, NGW = F.G * NWAVES;
    LAS f32x4* ca = (LAS f32x4*)(F.lds + RING_OFF); LAS f32x4* cb = ca + 5 * (DM / 4); LAS f32x4* cg = cb + 5 * (DM / 4);
    { f32x4 g[5], sc[5], sh[5];
#pragma unroll
      for (int r = 0; r < 5; ++r) { const float* shift = modl + (size_t)r * D6 + (which ? 3 * DM : 0);
          g[r] = ((const f32x4*)gain)[F.tid]; sc[r] = ((const f32x4*)(shift + DM))[F.tid]; sh[r] = ((const f32x4*)shift)[F.tid]; }
      f32x4 gt4 = (f32x4){0.f, 0.f, 0.f, 0.f}; if (slabgate != nullptr) gt4 = ((const f32x4*)slabgate)[F.tid];
      __builtin_amdgcn_sched_barrier(0);
#pragma unroll
      for (int r = 0; r < 5; ++r) { ca[r * (DM / 4) + F.tid] = g[r] * (sc[r] + 1.0f); cb[r * (DM / 4) + F.tid] = sh[r]; }
      cg[F.tid] = gt4; }
    __syncthreads();
    int m = gw, mstep = NGW, mlim = M;
    if (slabgate != nullptr) { const int idx = (F.wave >> 1) + 4 * F.vcu; if (F.wave & 1) { m = idx; mstep = NGW / 2; mlim = 8192; } else { m = 8192 + idx; mstep = M; } }
#define NM_NEXT(mm) do { while ((mm) < mlim && skip_ctx && ((mm) % TT) < CTXL) (mm) += mstep; } while (0)
    NM_NEXT(m);
    const bool fromin = (l == 0 && which == 0);
#define NM_ROW(mm) ((const f32x4*)(fromin ? ((mm) % TT < CTXL ? a.in[I_CTX] + ((size_t)((mm) / TT) * CTXL + (mm) % TT) * DM : a.in[I_X] + ((size_t)((mm) / TT) * SEQ + ((mm) % TT - CTXL)) * DM) : X + (size_t)(mm) * DM) + F.lane)
#define NM_DO(v, m, SLAB) do { \
        const int b = (m) / TT, t = (m) - b * TT; const int r = (t < CTXL) ? 4 : b; \
        float ss = 0.f; \
        if (SLAB) { \
            const f32x4* sl = (const f32x4*)((const float*)(a.ws + WS_SLAB) + (size_t)((m) - 8192) * DM) + F.lane; \
            _Pragma("unroll") for (int jp = 0; jp < 4; ++jp) {                 \
                f32x4 sv[2][8]; \
                _Pragma("unroll") for (int jj = 0; jj < 2; ++jj) \
                    _Pragma("unroll") for (int ks = 0; ks < 8; ++ks) sv[jj][ks] = sl[(size_t)ks * 1024 * (DM / 4) + 64 * (2 * jp + jj)]; \
                __builtin_amdgcn_sched_barrier(0); \
                _Pragma("unroll") for (int jj = 0; jj < 2; ++jj) { const int j = 2 * jp + jj; \
                    const f32x4 sum = ((sv[jj][0] + sv[jj][1]) + (sv[jj][2] + sv[jj][3])) + ((sv[jj][4] + sv[jj][5]) + (sv[jj][6] + sv[jj][7])); \
                    v[j] = v[j] + cg[F.lane + 64 * j] * sum; \
                    ((f32x4*)(a.ws + WS_X) + (size_t)(m) * (DM / 4) + F.lane)[64 * j] = v[j]; } \
                __builtin_amdgcn_sched_barrier(0); } } \
        _Pragma("unroll") for (int j = 0; j < 8; ++j) ss += (v[j].x * v[j].x + v[j].y * v[j].y) + (v[j].z * v[j].z + v[j].w * v[j].w); \
        const float rstd = 1.0f / sqrtf(wave_sum(ss, F.lane) * (1.f / DM) + EPS); \
        if (fromin) { f32x4* xo = (f32x4*)(a.ws + WS_X) + (size_t)(m) * (DM / 4) + F.lane; \
            _Pragma("unroll") for (int j = 0; j < 8; ++j) xo[64 * j] = v[j]; } \
        v2u* o8 = (v2u*)(H + (size_t)(m) * DM) + F.lane; \
        _Pragma("unroll") for (int j = 0; j < 8; ++j) { \
            const f32x4 h = v[j] * rstd * ca[r * (DM / 4) + F.lane + 64 * j] + cb[r * (DM / 4) + F.lane + 64 * j]; \
            v2u w; w.x = pk2(h.x, h.y); w.y = pk2(h.z, h.w); o8[64 * j] = w; } } while (0)
    if (slabgate != nullptr && m >= 8192) {
        if (m < mlim) { f32x4 va[8]; const f32x4* xr = NM_ROW(m);
#pragma unroll
            for (int j = 0; j < 8; ++j) va[j] = xr[64 * j];
            NM_DO(va, m, true); }
    } else
    while (m < mlim) {
        int m1 = m + mstep; NM_NEXT(m1);
        f32x4 va[8], vb[8];
        { const f32x4* xr = NM_ROW(m);
#pragma unroll
          for (int j = 0; j < 8; ++j) va[j] = xr[64 * j]; }
        if (m1 < mlim) { const f32x4* xr = NM_ROW(m1);
#pragma unroll
          for (int j = 0; j < 8; ++j) vb[j] = xr[64 * j]; }
        __builtin_amdgcn_sched_barrier(0);
        NM_DO(va, m, false);
        if (m1 < mlim) NM_DO(vb, m1, false);
        m = m1 + mstep; NM_NEXT(m);
    }
#undef NM_DO
#undef NM_NEXT
#undef NM_ROW
}
__device__ __forceinline__ void final_norm_phase(const Frame& F0, const Args& a0) {
    const Frame F = relaunder(F0); const Args a = relaunder_args(a0);
    const float* X = (const float*)(a.ws + WS_X); const float* gain = a.in[I_NFINAL];
    const int gw = F.vcu * NWAVES + F.wave, NGW = F.G * NWAVES;
    f32x4 gn[8];
#pragma unroll
    for (int j = 0; j < 8; ++j) gn[j] = *(const f32x4*)(gain + (F.lane + 64 * j) * 4);
    for (int r0 = gw; r0 < NB * SEQ; r0 += 2 * NGW) {
        const int r1 = r0 + NGW; const bool ok1 = r1 < NB * SEQ;
        f32x4 va[8], vb[8];
        { const int b = r0 / SEQ, t = r0 - b * SEQ; const f32x4* xr = (const f32x4*)(X + ((size_t)b * TT + CTXL + t) * DM) + F.lane;
#pragma unroll
          for (int j = 0; j < 8; ++j) va[j] = xr[64 * j]; }
        if (ok1) { const int b = r1 / SEQ, t = r1 - b * SEQ; const f32x4* xr = (const f32x4*)(X + ((size_t)b * TT + CTXL + t) * DM) + F.lane;
#pragma unroll
          for (int j = 0; j < 8; ++j) vb[j] = xr[64 * j]; }
        __builtin_amdgcn_sched_barrier(0);
#define FN_ROW(v, r) do { float ss = 0.f; \
        _Pragma("unroll") for (int j = 0; j < 8; ++j) ss += (v[j].x * v[j].x + v[j].y * v[j].y) + (v[j].z * v[j].z + v[j].w * v[j].w); \
        const float rstd = 1.0f / sqrtf(wave_sum(ss, F.lane) * (1.f / DM) + EPS); \
        f32x4* o = (f32x4*)(a.out + (size_t)(r) * DM) + F.lane; \
        _Pragma("unroll") for (int j = 0; j < 8; ++j) o[64 * j] = v[j] * rstd * gn[j]; } while (0)
        FN_ROW(va, r0);
        if (ok1) FN_ROW(vb, r1);
#undef FN_ROW
    }
}

typedef short bf16x8 __attribute__((ext_vector_type(8)));
typedef short s16x4 __attribute__((ext_vector_type(4)));
constexpr int AT_KP = 272, AT_VP = 288, AT_KB = 64 * AT_KP, AT_VB = 64 * AT_VP, AT_STG = AT_KB + AT_VB;
static_assert(2 * AT_STG <= RING_BYTES, "attention LDS");
typedef __bf16 bf16x2n __attribute__((ext_vector_type(2)));
typedef float f32x2n __attribute__((ext_vector_type(2)));
__device__ __forceinline__ unsigned cvtpk(float lo, float hi) { return __builtin_bit_cast(unsigned, __builtin_convertvector((f32x2n){lo, hi}, bf16x2n)); }
__device__ __forceinline__ bf16x8 pack8(const f32x4& a, const f32x4& b) {
    v4u w; w.x = cvtpk(a[0], a[1]); w.y = cvtpk(a[2], a[3]); w.z = cvtpk(b[0], b[1]); w.w = cvtpk(b[2], b[3]);
    return __builtin_bit_cast(bf16x8, w);
}
template <int OFF>
__device__ __forceinline__ void tr8(unsigned va, s16x4 (&r)[8]) {
    asm volatile("ds_read_b64_tr_b16 %0, %8 offset:%9\n\t"
                 "ds_read_b64_tr_b16 %1, %8 offset:%10\n\t"
                 "ds_read_b64_tr_b16 %2, %8 offset:%11\n\t"
                 "ds_read_b64_tr_b16 %3, %8 offset:%12\n\t"
                 "ds_read_b64_tr_b16 %4, %8 offset:%13\n\t"
                 "ds_read_b64_tr_b16 %5, %8 offset:%14\n\t"
                 "ds_read_b64_tr_b16 %6, %8 offset:%15\n\t"
                 "ds_read_b64_tr_b16 %7, %8 offset:%16\n\t"
                 "s_waitcnt lgkmcnt(0)"
                 : "=&v"(r[0]), "=&v"(r[1]), "=&v"(r[2]), "=&v"(r[3]), "=&v"(r[4]), "=&v"(r[5]), "=&v"(r[6]), "=&v"(r[7])
                 : "v"(va), "i"(OFF), "i"(OFF + 16 * AT_VP), "i"(OFF + 32 * AT_VP), "i"(OFF + 48 * AT_VP),
                   "i"(OFF + 32), "i"(OFF + 32 + 16 * AT_VP), "i"(OFF + 32 + 32 * AT_VP), "i"(OFF + 32 + 48 * AT_VP)
                 : "memory");
}
template <int DTP>
__device__ __forceinline__ void pv_pair(f32x4 (&ot)[8], unsigned va, const bf16x8 (&Pf)[2]) {
    s16x4 r[8]; tr8<DTP * 64>(va, r);
    const bf16x8 a00 = __builtin_shufflevector(r[0], r[1], 0, 1, 2, 3, 4, 5, 6, 7), a01 = __builtin_shufflevector(r[2], r[3], 0, 1, 2, 3, 4, 5, 6, 7);
    const bf16x8 a10 = __builtin_shufflevector(r[4], r[5], 0, 1, 2, 3, 4, 5, 6, 7), a11 = __builtin_shufflevector(r[6], r[7], 0, 1, 2, 3, 4, 5, 6, 7);
    ot[2 * DTP] = __builtin_amdgcn_mfma_f32_16x16x32_bf16(a00, Pf[0], ot[2 * DTP], 0, 0, 0);
    ot[2 * DTP] = __builtin_amdgcn_mfma_f32_16x16x32_bf16(a01, Pf[1], ot[2 * DTP], 0, 0, 0);
    ot[2 * DTP + 1] = __builtin_amdgcn_mfma_f32_16x16x32_bf16(a10, Pf[0], ot[2 * DTP + 1], 0, 0, 0);
    ot[2 * DTP + 1] = __builtin_amdgcn_mfma_f32_16x16x32_bf16(a11, Pf[1], ot[2 * DTP + 1], 0, 0, 0);
}
__device__ __forceinline__ void attn_phase(const Frame& F0, const Args& a0, int l, int u0, int ustride, int ucount, int ulimit, int uextra, bool last) {
    const Frame F = relaunder(F0); const Args a = relaunder_args(a0);
    const bf16* Z = (const bf16*)(a.ws + WS_Z); bf16* MIX = (bf16*)(a.ws + WS_MIX);
    const float* sink = a.in[I_SINK] + l * 8;
    const int wave = F.wave, lane = F.lane, c = lane & 15, g = lane >> 4, tid = F.tid;
    LAS unsigned char* lds = F.lds + RING_OFF;
    const unsigned ldsbase = (unsigned)(size_t)lds;
    const unsigned va_lane = (unsigned)((4 * g + (c >> 2)) * AT_VP + 8 * (c & 3));
    const int srow0 = tid >> 4, sch = tid & 15;
    constexpr float SC = 0.08838834764831845f * 1.4426950408889634f;
    const int nall = last ? 512 : 576, nunits = nall < ulimit ? nall : ulimit;
    for (int ui = 0; ui <= ucount; ++ui) {
        const int u = (ui < ucount) ? u0 + ui * ustride : uextra;
        if (ui < ucount ? (u >= nunits) : (u < 0 || u >= nall)) continue;
        int hq, qb, kvh, b; bool isctx;
        if (u < 512) { hq = u & 3; qb = (u >> 2) & 15; kvh = (u >> 6) & 1; b = u >> 7; isctx = false; }
        else { const int uc = u - 512; hq = uc & 3; qb = (uc >> 2) & 1; kvh = (uc >> 3) & 1; b = uc >> 4; isctx = true; }
        const int head = kvh * 4 + hq;
        const int qrow0 = b * TT + (isctx ? qb * 128 : CTXL + qb * 128);
        const int firstb = isctx ? 0 : (qb > 0 ? qb - 1 : 0), lastb = isctx ? -1 : (qb < 15 ? qb + 1 : 15);
        const int nloc = isctx ? 0 : (lastb - firstb + 1) * 2, NT = nloc + 4;
        bf16x8 Qf[4];
        { const bf16* qp = Z + (size_t)(qrow0 + 16 * wave + c) * ZP + head * 128 + 8 * g;
#pragma unroll
          for (int kb = 0; kb < 4; ++kb) Qf[kb] = *(const bf16x8*)(qp + 32 * kb); }
        float m = sink[head] * 1.4426950408889634f, lsum = (g == 0) ? 1.f : 0.f;
        f32x4 ot[8];
#pragma unroll
        for (int dt = 0; dt < 8; ++dt) ot[dt] = (f32x4){0.f, 0.f, 0.f, 0.f};
        const size_t kvcol = (size_t)OFF_AK + kvh * 128 + sch * 8;
        v4u sk0, sk1, sv0, sv1;
#define AT_TILE_ROW(ti) ((ti) < nloc ? b * TT + CTXL + (firstb + ((ti) >> 1)) * 128 + ((ti) & 1) * 64 : b * TT + ((ti) - nloc) * 64)
#define AT_LOAD(ti) do { const bf16* src = Z + (size_t)(AT_TILE_ROW(ti) + srow0) * ZP + kvcol; \
            sk0 = *(const v4u*)(src); sk1 = *(const v4u*)(src + (size_t)32 * ZP); sv0 = *(const v4u*)(src + 256); sv1 = *(const v4u*)(src + (size_t)32 * ZP + 256); } while (0)
#define AT_STORE(buf) do { LAS unsigned char* kb_ = lds + (buf) * AT_STG; \
            *(LAS v4u*)(kb_ + srow0 * AT_KP + sch * 16) = sk0; *(LAS v4u*)(kb_ + (srow0 + 32) * AT_KP + sch * 16) = sk1; \
            *(LAS v4u*)(kb_ + AT_KB + srow0 * AT_VP + sch * 16) = sv0; *(LAS v4u*)(kb_ + AT_KB + (srow0 + 32) * AT_VP + sch * 16) = sv1; } while (0)
        AT_LOAD(0); AT_STORE(0); __syncthreads();
        for (int ti = 0; ti < NT; ++ti) {
            if (ti + 1 < NT) AT_LOAD(ti + 1);
            const LAS unsigned char* Kb = lds + (ti & 1) * AT_STG;
            const unsigned va = ldsbase + (unsigned)((ti & 1) * AT_STG + AT_KB) + va_lane;
            int type = 0; const int sub = ti & 1;
            if (ti < nloc) { const int blk = firstb + (ti >> 1); type = blk < qb ? 1 : (blk > qb ? 2 : 0); }
            f32x4 st[4]; bf16x8 kf[16];
#pragma unroll
            for (int i = 0; i < 16; ++i) kf[i] = *(const LAS bf16x8*)(Kb + (16 * (i >> 2) + c) * AT_KP + (32 * (i & 3) + 8 * g) * 2);
            __builtin_amdgcn_sched_barrier(0);
#pragma unroll
            for (int kt = 0; kt < 4; ++kt) st[kt] = (f32x4){0.f, 0.f, 0.f, 0.f};
#pragma unroll
            for (int kb = 0; kb < 4; ++kb)
#pragma unroll
                for (int kt = 0; kt < 4; ++kt) st[kt] = __builtin_amdgcn_mfma_f32_16x16x32_bf16(kf[4 * kt + kb], Qf[kb], st[kt], 0, 0, 0);
            s16x4 vr[32];
#pragma unroll
            for (int dtp = 0; dtp < 4; ++dtp)
#pragma unroll
                for (int e = 0; e < 8; ++e) vr[8 * dtp + e] = __builtin_amdgcn_ds_read_tr16_b64_v4i16((LAS s16x4*)(va + (unsigned)(dtp * 64 + (e >> 2) * 32 + (e & 3) * 16 * AT_VP)));
            __builtin_amdgcn_sched_barrier(0);
            float mx = -1e30f; const int ii = 16 * wave + c;
            if (type != 0) {
                const int jb = 64 * sub + 4 * g, lo = (type == 1 ? ii : -4096) - jb, span = (type == 2 ? ii : 4096) - jb - lo;
#pragma unroll
                for (int kt = 0; kt < 4; ++kt)
#pragma unroll
                    for (int r = 0; r < 4; ++r) st[kt][r] = ((unsigned)(16 * kt + r - lo) <= (unsigned)span) ? st[kt][r] : -1e30f;
            }
#pragma unroll
            for (int kt = 0; kt < 4; ++kt)
#pragma unroll
                for (int r = 0; r < 4; ++r) { const float t = st[kt][r] * SC; st[kt][r] = t; mx = fmaxf(mx, t); }
            mx = fmaxf(mx, shx(mx, 16, lane)); mx = fmaxf(mx, shx(mx, 32, lane));
            const float mn = fmaxf(m, mx), alpha = __builtin_amdgcn_exp2f(m - mn); m = mn;
            lsum *= alpha;
#pragma unroll
            for (int dt = 0; dt < 8; ++dt) ot[dt] = ot[dt] * alpha;
            float ps = 0.f;
#pragma unroll
            for (int kt = 0; kt < 4; ++kt)
#pragma unroll
                for (int r = 0; r < 4; ++r) { const float p = __builtin_amdgcn_exp2f(st[kt][r] - mn); st[kt][r] = p; ps += p; }
            lsum += ps;
            bf16x8 Pf[2]; Pf[0] = pack8(st[0], st[1]); Pf[1] = pack8(st[2], st[3]);
#pragma unroll
            for (int dtp = 0; dtp < 4; ++dtp) {
                const bf16x8 a00 = __builtin_shufflevector(vr[8 * dtp + 0], vr[8 * dtp + 1], 0, 1, 2, 3, 4, 5, 6, 7), a01 = __builtin_shufflevector(vr[8 * dtp + 2], vr[8 * dtp + 3], 0, 1, 2, 3, 4, 5, 6, 7);
                const bf16x8 a10 = __builtin_shufflevector(vr[8 * dtp + 4], vr[8 * dtp + 5], 0, 1, 2, 3, 4, 5, 6, 7), a11 = __builtin_shufflevector(vr[8 * dtp + 6], vr[8 * dtp + 7], 0, 1, 2, 3, 4, 5, 6, 7);
                ot[2 * dtp] = __builtin_amdgcn_mfma_f32_16x16x32_bf16(a00, Pf[0], ot[2 * dtp], 0, 0, 0);
                ot[2 * dtp] = __builtin_amdgcn_mfma_f32_16x16x32_bf16(a01, Pf[1], ot[2 * dtp], 0, 0, 0);
                ot[2 * dtp + 1] = __builtin_amdgcn_mfma_f32_16x16x32_bf16(a10, Pf[0], ot[2 * dtp + 1], 0, 0, 0);
                ot[2 * dtp + 1] = __builtin_amdgcn_mfma_f32_16x16x32_bf16(a11, Pf[1], ot[2 * dtp + 1], 0, 0, 0); }
            if (ti + 1 < NT) AT_STORE((ti + 1) & 1);
            __syncthreads();
        }
#undef AT_TILE_ROW
#undef AT_LOAD
#undef AT_STORE
        lsum += shx(lsum, 16, lane); lsum += shx(lsum, 32, lane);
        const float inv = 1.0f / lsum;
        bf16* op = MIX + (size_t)(qrow0 + 16 * wave + c) * 2048 + head * 128 + 4 * g;
#pragma unroll
        for (int dt = 0; dt < 8; ++dt) { v2u w; w.x = cvtpk(ot[dt][0] * inv, ot[dt][1] * inv); w.y = cvtpk(ot[dt][2] * inv, ot[dt][3] * inv); *(v2u*)(op + 16 * dt) = w; }
    }
}

constexpr int GD_PITCH = 272;
constexpr int GD_QS = 0, GD_KS = 17408, GD_VS = 34816, GD_AD = 52224  , GD_MD = 89088  ,
              GD_QKB = 123904, GD_QKP = 144, GD_GATES = 142336, GD_MPP = 144;
constexpr int GD_REC = 57344;
constexpr int REP_SLEEP = 0, REP_GA = 1, REP_GC = 1, REP_GD = 1, REP_GD5 = 1, REP_GD6 = 1, REP_GE = 1;
static_assert(GD_AD + 36864 <= GD_MD && GD_MD + 34816 <= GD_QKB && GD_QKB + 18432 <= GD_GATES && GD_GATES + 2560 <= RING_BYTES, "gdn LDS");
__device__ __forceinline__ float softplusf(float x) { return x > 20.f ? x : __logf(1.0f + __expf(x)); }

__device__ __forceinline__ bf16x8 gd_tr_pair(unsigned a0, unsigned a1) {
    s16x4 lo, hi;
    asm volatile("ds_read_b64_tr_b16 %0, %2\n\tds_read_b64_tr_b16 %1, %3\n\ts_waitcnt lgkmcnt(0)" : "=&v"(lo), "=&v"(hi) : "v"(a0), "v"(a1) : "memory");
    return __builtin_shufflevector(lo, hi, 0, 1, 2, 3, 4, 5, 6, 7);
}
__device__ __forceinline__ void gdn_prep_phase(const Frame& F0, const Args& a0, int l) {
    const Frame F = relaunder(F0); const Args a = relaunder_args(a0);
    const bf16* Z = (const bf16*)(a.ws + WS_Z); const float* AB = (const float*)(a.ws + WS_AB);
    const float* convw = a.in[I_CONVW] + (size_t)l * 5 * 3072; const float* alog = a.in[I_ALOG] + l * 16; const float* dtb = a.in[I_DTB] + l * 16;
    unsigned char* RECB = a.ws + WS_GREC; float* UB = (float*)(a.ws + WS_GU); float* GLB = (float*)(a.ws + WS_GL);
    LAS unsigned char* lds = F.lds + RING_OFF;
    const int tid = F.tid, lane = F.lane, wave = F.wave;
    LAS float* gcs = (LAS float*)(lds + GD_GATES); LAS float* bts = gcs + 128; LAS float* egs = gcs + 256; LAS float* ekd = gcs + 384;
    v2u zr[20]; f32x4 cw[5]; float pab0 = 0.f, pab1 = 0.f;
#define GD_PREFETCH(un_) do { const int c_ = (un_) % 36, h_ = ((un_) / 36) & 7, b_ = (un_) / 288, m0_ = b_ * TT + 64 * c_; \
        const int tl0_ = (c_ < 4) ? 64 * c_ : 64 * (c_ - 4), L_ = (c_ < 4) ? CTXL : SEQ; \
        int tp_; asm volatile("v_mbcnt_lo_u32_b32 %0, -1, 0\n\tv_mbcnt_hi_u32_b32 %0, -1, %0" : "=v"(tp_)); \
        { const int q4_ = tp_ & 31, part_ = (wave < 4) ? (tp_ >> 5) : 2, r0_ = (wave < 4) ? 16 * wave : 8 * (2 * (wave - 4) + (tp_ >> 5)), ch_ = part_ * 1024 + h_ * 128 + 4 * q4_; \
            _Pragma("unroll") for (int j_ = 0; j_ < 5; ++j_) cw[j_] = *(const f32x4*)(convw + j_ * 3072 + ch_); \
            _Pragma("unroll") for (int rr_ = 0; rr_ < 20; ++rr_) if (rr_ < 12 || wave < 4) { const int tloc_ = tl0_ + r0_ + rr_ - 2, tcl_ = tloc_ < 0 ? 0 : (tloc_ >= L_ ? L_ - 1 : tloc_); \
                zr[rr_] = *(const v2u*)(Z + (size_t)(m0_ - tl0_ + tcl_) * ZP + OFF_GQKV + ch_); } } \
        { const int d_ = wave & 1, tok_ = d_ ? 63 - tp_ : tp_; pab0 = AB[(size_t)(m0_ + tok_) * 32 + d_ * 16 + h_]; pab1 = AB[(size_t)(m0_ + tok_) * 32 + d_ * 16 + 8 + h_]; } } while (0)
    if (F.vcu < NB * 8 * 36) GD_PREFETCH(F.vcu);
    for (int u = F.vcu; u < NB * 8 * 36; u += F.G) {
        const int c = u % 36, h = (u / 36) & 7, b = u / 288;
        LDS_BARRIER();
        int ta_; asm volatile("v_mbcnt_lo_u32_b32 %0, -1, 0\n\tv_mbcnt_hi_u32_b32 %0, -1, %0" : "=v"(ta_));
#define GD_CONV(NR, NORM) do { \
            { const int tl0 = (c < 4) ? 64 * c : 64 * (c - 4), L = (c < 4) ? CTXL : SEQ; \
              if (tl0 + r0 == 0) { zr[0] = (v2u){0u, 0u}; zr[1] = (v2u){0u, 0u}; } \
              if (tl0 + r0 + NR == L) { zr[NR + 2] = (v2u){0u, 0u}; zr[NR + 3] = (v2u){0u, 0u}; } } \
            f32x4 y[NR]; float ss[NR]; \
            _Pragma("unroll") for (int r = 0; r < NR; ++r) { \
                y[r] = (f32x4){0.f, 0.f, 0.f, 0.f}; \
                _Pragma("unroll") for (int j = 0; j < 5; ++j) { const v2u z = zr[r + j]; y[r] += (f32x4){bflo(z.x), bfhi(z.x), bflo(z.y), bfhi(z.y)} * cw[j]; } \
                _Pragma("unroll") for (int e = 0; e < 4; ++e) y[r][e] = y[r][e] * __builtin_amdgcn_rcpf(1.f + __expf(-y[r][e])); \
                ss[r] = (y[r][0] * y[r][0] + y[r][1] * y[r][1]) + (y[r][2] * y[r][2] + y[r][3] * y[r][3]); } \
            if (NORM) {                                             \
                _Pragma("unroll") for (int o = 1; o < 32; o <<= 1) { float t[NR]; \
                    _Pragma("unroll") for (int r = 0; r < NR; ++r) t[r] = shx(ss[r], o, ta_); \
                    _Pragma("unroll") for (int r = 0; r < NR; ++r) ss[r] += t[r]; } \
                _Pragma("unroll") for (int r = 0; r < NR; ++r) y[r] = y[r] * (__builtin_amdgcn_rsqf(ss[r] + EPS) * (part == 0 ? 0.08838834764831845f : 1.0f)); } \
            _Pragma("unroll") for (int r = 0; r < NR; ++r) { v2u o; o.x = cvtpk(y[r][0], y[r][1]); o.y = cvtpk(y[r][2], y[r][3]); \
                *(LAS v2u*)(lds + part * 17408 + (r0 + r) * GD_PITCH + q4 * 8) = o; } } while (0)
        { const int q4 = ta_ & 31;
          if (wave < 4) { const int part = ta_ >> 5, r0 = 16 * wave; GD_CONV(16, true); }
          else { const int part = 2, r0 = 8 * (2 * (wave - 4) + (ta_ >> 5)); GD_CONV(8, false); } }
#undef GD_CONV
        if (wave >= 6) { int lb_; asm volatile("v_mbcnt_lo_u32_b32 %0, -1, 0\n\tv_mbcnt_hi_u32_b32 %0, -1, %0" : "=v"(lb_)); const int lane = lb_;
            const int d = wave - 6;
            float gc = -__expf(alog[d * 8 + h]) * softplusf(pab0 + dtb[d * 8 + h]);
            const float bt = 1.f / (1.f + __expf(-pab1));
#pragma unroll
            for (int o = 1; o < 64; o <<= 1) { const float t = __builtin_bit_cast(float, __builtin_amdgcn_ds_bpermute(((lane - o) & 63) << 2, __builtin_bit_cast(int, gc))); if (lane >= o) gc += t; }
            const float tot = __builtin_bit_cast(float, __builtin_amdgcn_readlane(__builtin_bit_cast(int, gc), 63));
            gcs[d * 64 + lane] = gc; bts[d * 64 + lane] = bt; egs[d * 64 + lane] = __expf(gc); ekd[d * 64 + lane] = __expf(tot - gc);
            if (lane == 63) GLB[(size_t)((b * 8 + h) * 2 + d) * 36 + c] = __expf(tot); }
        if (wave == 5) gcs[512 + (F.lane)] = 1.0f;
        LDS_BARRIER();
        for (int repc = 0; repc < REP_GC; ++repc) {
            int tl_; asm volatile("v_mbcnt_lo_u32_b32 %0, -1, 0\n\tv_mbcnt_hi_u32_b32 %0, -1, %0" : "=v"(tl_)); const int lane = tl_;
            const int d = wave >> 2, rt = wave & 3, i = lane & 15, g = lane >> 4;
            const int prow = 16 * rt + i, trow = d ? 63 - prow : prow;
            bf16x8 aK[4], aQ[4];
#pragma unroll
            for (int kb = 0; kb < 4; ++kb) { aK[kb] = *(const LAS bf16x8*)(lds + GD_KS + trow * GD_PITCH + (32 * kb + 8 * g) * 2); aQ[kb] = *(const LAS bf16x8*)(lds + GD_QS + trow * GD_PITCH + (32 * kb + 8 * g) * 2); }
            LAS unsigned char* AD = lds + GD_AD + d * 17408; LAS unsigned char* QKB = lds + GD_QKB + d * 9216;
            float gpv[4], btv[4];
#pragma unroll
            for (int r = 0; r < 4; ++r) { gpv[r] = gcs[d * 64 + 16 * rt + 4 * g + r]; btv[r] = bts[d * 64 + 16 * rt + 4 * g + r]; }
#pragma unroll
            for (int ct = 0; ct < 4; ++ct) {
                if (ct <= rt) {
                    const int pcol = 16 * ct + i, tcol = d ? 63 - pcol : pcol;
                    f32x4 kk = (f32x4){0.f, 0.f, 0.f, 0.f}, qk = (f32x4){0.f, 0.f, 0.f, 0.f};
#pragma unroll
                    for (int kb = 0; kb < 4; ++kb) { const bf16x8 bK = *(const LAS bf16x8*)(lds + GD_KS + tcol * GD_PITCH + (32 * kb + 8 * g) * 2);
                        kk = __builtin_amdgcn_mfma_f32_16x16x32_bf16(aK[kb], bK, kk, 0, 0, 0); qk = __builtin_amdgcn_mfma_f32_16x16x32_bf16(aQ[kb], bK, qk, 0, 0, 0); }
                    const int pq = 16 * ct + i; const float gq = gcs[d * 64 + pq];
#pragma unroll
                    for (int r = 0; r < 4; ++r) { const int p = 16 * rt + 4 * g + r; const float dec = __expf(fminf(gpv[r] - gq, 0.f));
                        *(LAS float*)(AD + p * GD_PITCH + pq * 4) = (pq < p) ? btv[r] * kk[r] * dec : 0.f;
                        *(LAS bf16*)(QKB + p * GD_QKP + pq * 2) = (bf16)f2bf((pq <= p) ? qk[r] * dec : 0.f); }
                } else {
#pragma unroll
                    for (int r = 0; r < 4; ++r) *(LAS bf16*)(QKB + (16 * rt + 4 * g + r) * GD_QKP + (16 * ct + i) * 2) = (bf16)0;
                }
            }
        }
        LDS_BARRIER();
        if (u + F.G < NB * 8 * 36) GD_PREFETCH(u + F.G);
        {
            int td_; asm volatile("v_mbcnt_lo_u32_b32 %0, -1, 0\n\tv_mbcnt_hi_u32_b32 %0, -1, %0" : "=v"(td_)); const int lane = td_, tid2 = td_ + wave * 64;
            const int cc = lane & 15, g = lane >> 4;
            for (int repd = 0; repd < REP_GD; ++repd) {
            if (tid2 < 128) { const int d = tid2 >> 6, bi = (tid2 >> 4) & 3, col = tid2 & 15;
                const LAS unsigned char* Ab = lds + GD_AD + d * 17408 + (16 * bi) * GD_PITCH + (16 * bi) * 4; LAS unsigned char* Mb = lds + GD_MD + d * 17408 + (16 * bi) * GD_PITCH + (16 * bi) * 4;
                float x[16];
#pragma unroll
                for (int r = 0; r < 16; ++r) { float acc = (r == col) ? 1.f : 0.f;
                    f32x4 av[4];
#pragma unroll
                    for (int q4 = 0; q4 < 4; ++q4) if (4 * q4 < r) av[q4] = *(const LAS f32x4*)(Ab + r * GD_PITCH + q4 * 16);
#pragma unroll
                    for (int j = 0; j < 16; ++j) if (j < r) acc -= av[j >> 2][j & 3] * x[j];
                    x[r] = acc; *(LAS float*)(Mb + r * GD_PITCH + col * 4) = acc; }
            }
            LDS_BARRIER();
#define GD_AEL(d_, r_, c_) (*(const LAS float*)(lds + GD_AD + (d_) * 17408 + (r_) * GD_PITCH + (c_) * 4))
#define GD_MEL(d_, r_, c_) (*(LAS float*)(lds + GD_MD + (d_) * 17408 + (r_) * GD_PITCH + (c_) * 4))
#pragma unroll
            for (int lev = 1; lev <= 3; ++lev) {
                const int nb = 4 - lev;
                if (wave < 2 * nb) { const int d = wave / nb, bj = wave % nb, bi = bj + lev;
                    f32x4 t = (f32x4){0.f, 0.f, 0.f, 0.f};
#pragma unroll
                    for (int k = 0; k < 3; ++k) if (k < lev) { const int bk = bj + k;
#pragma unroll
                        for (int s = 0; s < 4; ++s) t = __builtin_amdgcn_mfma_f32_16x16x4f32(GD_AEL(d, 16 * bi + cc, 16 * bk + 4 * s + g), GD_MEL(d, 16 * bk + 4 * s + g, 16 * bj + cc), t, 0, 0, 0); }
                    f32x4 m2 = (f32x4){0.f, 0.f, 0.f, 0.f};
#pragma unroll
                    for (int s = 0; s < 4; ++s) m2 = __builtin_amdgcn_mfma_f32_16x16x4f32(GD_MEL(d, 16 * bi + cc, 16 * bi + 4 * g + s), t[s], m2, 0, 0, 0);
#pragma unroll
                    for (int r = 0; r < 4; ++r) GD_MEL(d, 16 * bi + 4 * g + r, 16 * bj + cc) = -m2[r];
                }
                LDS_BARRIER();
            }
            }
#undef GD_AEL
            for (int repd5 = 0; repd5 < REP_GD5; ++repd5) {
            { const int d = tid2 >> 8, p = (tid2 >> 2) & 63, q = tid2 & 3;
                float mv[16];
                if (16 * q <= p) {
#pragma unroll
                    for (int q4 = 0; q4 < 4; ++q4) { const f32x4 v4 = *(const LAS f32x4*)(lds + GD_MD + d * 17408 + p * GD_PITCH + (16 * q + 4 * q4) * 4); mv[4 * q4] = v4.x; mv[4 * q4 + 1] = v4.y; mv[4 * q4 + 2] = v4.z; mv[4 * q4 + 3] = v4.w; }
                } else {
#pragma unroll
                    for (int e = 0; e < 16; ++e) mv[e] = 0.f; }
                float su[16], sw[16];
#pragma unroll
                for (int e = 0; e < 16; ++e) { const int pp = 16 * q + e; const float m = (pp <= p) ? mv[e] : 0.f, bt = bts[d * 64 + pp]; su[e] = m * bt; sw[e] = m * bt * egs[d * 64 + pp]; }
                v4u ou0, ou1, ow0, ow1;
                if (d == 0) { ou0 = (v4u){cvtpk(su[0], su[1]), cvtpk(su[2], su[3]), cvtpk(su[4], su[5]), cvtpk(su[6], su[7])}; ou1 = (v4u){cvtpk(su[8], su[9]), cvtpk(su[10], su[11]), cvtpk(su[12], su[13]), cvtpk(su[14], su[15])};
                              ow0 = (v4u){cvtpk(sw[0], sw[1]), cvtpk(sw[2], sw[3]), cvtpk(sw[4], sw[5]), cvtpk(sw[6], sw[7])}; ow1 = (v4u){cvtpk(sw[8], sw[9]), cvtpk(sw[10], sw[11]), cvtpk(sw[12], sw[13]), cvtpk(sw[14], sw[15])}; }
                else        { ou0 = (v4u){cvtpk(su[15], su[14]), cvtpk(su[13], su[12]), cvtpk(su[11], su[10]), cvtpk(su[9], su[8])}; ou1 = (v4u){cvtpk(su[7], su[6]), cvtpk(su[5], su[4]), cvtpk(su[3], su[2]), cvtpk(su[1], su[0])};
                              ow0 = (v4u){cvtpk(sw[15], sw[14]), cvtpk(sw[13], sw[12]), cvtpk(sw[11], sw[10]), cvtpk(sw[9], sw[8])}; ow1 = (v4u){cvtpk(sw[7], sw[6]), cvtpk(sw[5], sw[4]), cvtpk(sw[3], sw[2]), cvtpk(sw[1], sw[0])}; }
                const int t0 = d ? 48 - 16 * q : 16 * q;
                LAS unsigned char* mu = lds + GD_AD + (d * 2) * 9216 + p * GD_MPP + t0 * 2; LAS unsigned char* mw = mu + 9216;
                LDS_BARRIER();
                *(LAS v4u*)mu = ou0; *(LAS v4u*)(mu + 16) = ou1; *(LAS v4u*)mw = ow0; *(LAS v4u*)(mw + 16) = ow1;
            }
            LDS_BARRIER();
            }
#undef GD_MEL
            if (u + F.G < NB * 8 * 36) {
                asm volatile("" : "+v"(zr[0]), "+v"(zr[1]), "+v"(zr[2]), "+v"(zr[3]), "+v"(zr[4]), "+v"(zr[5]), "+v"(zr[6]), "+v"(zr[7]), "+v"(zr[8]), "+v"(zr[9]), "+v"(zr[10]), "+v"(zr[11]));
                if (wave < 4) asm volatile("" : "+v"(zr[12]), "+v"(zr[13]), "+v"(zr[14]), "+v"(zr[15]), "+v"(zr[16]), "+v"(zr[17]), "+v"(zr[18]), "+v"(zr[19]));
                asm volatile("" : "+v"(cw[0]), "+v"(cw[1]), "+v"(cw[2]), "+v"(cw[3]), "+v"(cw[4]), "+v"(pab0), "+v"(pab1)); }
            for (int repd6 = 0; repd6 < REP_GD6; ++repd6)
            { const int d = wave >> 2, which = (wave >> 1) & 1, ct0 = 4 * (wave & 1);
                const size_t rec = (size_t)((b * 8 + h) * 2 + d) * 36 + c;
                const LAS unsigned char* img = lds + GD_AD + (d * 2 + which) * 9216;
                const unsigned srcb = (unsigned)(size_t)(lds + (which ? GD_KS : GD_VS)) + (unsigned)((8 * g + (cc >> 2)) * GD_PITCH + 8 * (cc & 3));
                bf16x8 afr[2][4];
#pragma unroll
                for (int kb = 0; kb < 2; ++kb)
#pragma unroll
                    for (int mt = 0; mt < 4; ++mt) afr[kb][mt] = *(const LAS bf16x8*)(img + (16 * mt + cc) * GD_MPP + (32 * kb + 8 * g) * 2);
                __builtin_amdgcn_sched_barrier(0);
#pragma unroll
                for (int ctl = 0; ctl < 4; ++ctl) { const int ct = ct0 + ctl;
                    f32x4 acc[4];
#pragma unroll
                    for (int mt = 0; mt < 4; ++mt) acc[mt] = (f32x4){0.f, 0.f, 0.f, 0.f};
                    bf16x8 bfr[2];
#pragma unroll
                    for (int kb = 0; kb < 2; ++kb) { const LAS s16x4* a0 = (const LAS s16x4*)(srcb + (unsigned)(32 * kb * GD_PITCH + 32 * ct));
                        const s16x4 lo = __builtin_amdgcn_ds_read_tr16_b64_v4i16((LAS s16x4*)a0), hi = __builtin_amdgcn_ds_read_tr16_b64_v4i16((LAS s16x4*)((const LAS unsigned char*)a0 + 4 * GD_PITCH));
                        bfr[kb] = __builtin_shufflevector(lo, hi, 0, 1, 2, 3, 4, 5, 6, 7); }
#pragma unroll
                    for (int kb = 0; kb < 2; ++kb)
#pragma unroll
                        for (int mt = 0; mt < 4; ++mt) acc[mt] = __builtin_amdgcn_mfma_f32_16x16x32_bf16(afr[kb][mt], bfr[kb], acc[mt], 0, 0, 0);
                    if (which == 0) { float* U = UB + rec * 8192 + (ct * 64 + lane) * 4;
#pragma unroll
                        for (int mt = 0; mt < 4; ++mt) *(f32x4*)(U + mt * 8 * 256) = acc[mt];
                    } else { LAS unsigned char* W = lds + GD_MD + d * 17408 + (16 * ct + cc) * 2;
#pragma unroll
                        for (int mt = 0; mt < 4; ++mt)
#pragma unroll
                            for (int r = 0; r < 4; ++r) *(LAS bf16*)(W + (16 * mt + 4 * g + r) * GD_PITCH) = (bf16)f2bf(-acc[mt][r]); }
                }
            }
        }
        LDS_BARRIER();
        for (int repe = 0; repe < REP_GE; ++repe) {
            int te_; asm volatile("v_mbcnt_lo_u32_b32 %0, -1, 0\n\tv_mbcnt_hi_u32_b32 %0, -1, %0" : "=v"(te_)); const int lane = te_;
            const int d = wave >> 2, wd = wave & 3, i = lane & 15, g = lane >> 4;
            unsigned char* rec = RECB + ((size_t)((b * 8 + h) * 2 + d) * 36 + c) * GD_REC;
            const LAS unsigned char* W = lds + GD_MD + d * 17408; const LAS unsigned char* QKB = lds + GD_QKB + d * 9216;
            unsigned char* recl = rec + lane * 16;
            { v2u lo[4], hi[4];
#pragma unroll
              for (int mt = 0; mt < 4; ++mt) { const LAS unsigned char* s = W + (16 * mt + i) * GD_PITCH + (32 * wd + 4 * g) * 2; lo[mt] = *(const LAS v2u*)s; hi[mt] = *(const LAS v2u*)(s + 32); }
#pragma unroll
              for (int mt = 0; mt < 4; ++mt) *(v4u*)(recl + (size_t)(4 * mt + wd) * 1024) = (v4u){lo[mt].x, lo[mt].y, hi[mt].x, hi[mt].y}; }
            { v2u lo[4], hi[4]; float sc[4];
#pragma unroll
              for (int mt = 0; mt < 4; ++mt) { const int p = 16 * mt + i, trow = d ? 63 - p : p; sc[mt] = egs[d * 64 + p];
                  const LAS unsigned char* s = lds + GD_QS + trow * GD_PITCH + (32 * wd + 4 * g) * 2; lo[mt] = *(const LAS v2u*)s; hi[mt] = *(const LAS v2u*)(s + 32); }
#pragma unroll
              for (int mt = 0; mt < 4; ++mt) { v4u out; const float c_ = sc[mt];
                  out.x = pk2(bflo(lo[mt].x) * c_, bfhi(lo[mt].x) * c_); out.y = pk2(bflo(lo[mt].y) * c_, bfhi(lo[mt].y) * c_); out.z = pk2(bflo(hi[mt].x) * c_, bfhi(hi[mt].x) * c_); out.w = pk2(bflo(hi[mt].y) * c_, bfhi(hi[mt].y) * c_);
                  *(v4u*)(recl + (size_t)(16 + 4 * mt + wd) * 1024) = out; } }
            { const int kb = wd & 1; float ek[8]; int trw[8];
#pragma unroll
              for (int j = 0; j < 8; ++j) { const int p = 32 * kb + 16 * (j >> 2) + 4 * g + (j & 3); trw[j] = (d ? 63 - p : p) * GD_PITCH; ek[j] = ekd[d * 64 + p]; }
              unsigned short kv[4][8];
#pragma unroll
              for (int jj = 0; jj < 4; ++jj) { const int dk = 16 * (2 * jj + (wd >> 1)) + i;
#pragma unroll
                  for (int j = 0; j < 8; ++j) kv[jj][j] = *(const LAS bf16*)(lds + GD_KS + trw[j] + dk * 2); }
#pragma unroll
              for (int jj = 0; jj < 4; ++jj) { v4u out;
                  out.x = pk2(bf2f(kv[jj][0]) * ek[0], bf2f(kv[jj][1]) * ek[1]); out.y = pk2(bf2f(kv[jj][2]) * ek[2], bf2f(kv[jj][3]) * ek[3]);
                  out.z = pk2(bf2f(kv[jj][4]) * ek[4], bf2f(kv[jj][5]) * ek[5]); out.w = pk2(bf2f(kv[jj][6]) * ek[6], bf2f(kv[jj][7]) * ek[7]);
                  *(v4u*)(recl + (size_t)(32 + 4 * jj + wd) * 1024) = out; } }
            { const int kb = wd & 1; v2u lo[2], hi[2];
#pragma unroll
              for (int jj = 0; jj < 2; ++jj) { const LAS unsigned char* s = QKB + (16 * (2 * jj + (wd >> 1)) + i) * GD_QKP + (32 * kb + 4 * g) * 2; lo[jj] = *(const LAS v2u*)s; hi[jj] = *(const LAS v2u*)(s + 32); }
#pragma unroll
              for (int jj = 0; jj < 2; ++jj) *(v4u*)(recl + (size_t)(48 + 4 * jj + wd) * 1024) = (v4u){lo[jj].x, lo[jj].y, hi[jj].x, hi[jj].y}; }
        }
    }
#undef GD_PREFETCH
}

__device__ __forceinline__ void gdn_scan_phase(const Frame& F0, const Args& a0, int nblk, bool last) {
    const Frame F = relaunder(F0); const Args a = relaunder_args(a0);
    const int chain = F.bx; if (chain >= nblk) return;
    const int d = chain & 1, h = (chain >> 1) & 7, b = chain >> 4;
    const unsigned char* REC = a.ws + WS_GREC + (size_t)chain * 36 * GD_REC; const float* UB = (const float*)(a.ws + WS_GU) + (size_t)chain * 36 * 8192; const float* GLB = (const float*)(a.ws + WS_GL) + (size_t)chain * 36;
    bf16* GOb = (bf16*)(a.ws + WS_GO2) + (size_t)d * M * 1024;
    LAS unsigned char* lds = F.lds + RING_OFF;
    LAS unsigned char* ost = lds + 2 * GD_REC;
    const int lane = F.lane, n = F.wave, cc = lane & 15, g = lane >> 4;
    f32x4 S[8];
#pragma unroll
    for (int t = 0; t < 8; ++t) S[t] = (f32x4){0.f, 0.f, 0.f, 0.f};
#define GD_CHUNK(s) (d ? ((s) < 4 ? 3 - (s) : 39 - (s)) : (s))
#define GD_GLDS(cidx, buf) do { const unsigned char* src_ = REC + (size_t)(cidx) * GD_REC + lane * 16; \
        _Pragma("unroll") for (int k_ = 0; k_ < 7; ++k_) __builtin_amdgcn_global_load_lds((const unsigned*)(src_ + (n + 8 * k_) * 1024), (LAS unsigned*)(lds + (buf) * GD_REC + (n + 8 * k_) * 1024), 16, 0, 0); } while (0)
    f32x4 un[4]; float gln;
    { const int c0 = GD_CHUNK(0); GD_GLDS(c0, 0);
#pragma unroll
      for (int mt = 0; mt < 4; ++mt) un[mt] = *(const f32x4*)(UB + (size_t)c0 * 8192 + ((mt * 8 + n) * 64 + lane) * 4);
      gln = GLB[c0]; }
    VM_WAIT(); __syncthreads();
    int cprev = -1;
#define GD_STORE_ROWS(cidx, buf) do { _Pragma("unroll") for (int i_ = 0; i_ < 2; ++i_) { const int id_ = F.tid + 512 * i_, row_ = id_ >> 4, ch_ = id_ & 15; \
        const v4u v_ = *(const LAS v4u*)(ost + (buf) * 16384 + row_ * 256 + ((ch_ ^ (((row_ >> 2) & 3) << 2)) * 16)); \
        *(v4u*)(GOb + (size_t)(b * TT + 64 * (cidx) + row_) * 1024 + h * 128 + ch_ * 8) = v_; } } while (0)
    for (int s = 0; s < 36; ++s) {
        const int c = GD_CHUNK(s);
        f32x4 V[4]; const float gl = gln;
#pragma unroll
        for (int mt = 0; mt < 4; ++mt) V[mt] = un[mt];
        if (cprev >= 0 && !(last && cprev < 4)) GD_STORE_ROWS(cprev, (s + 1) & 1);
        if (s + 1 < 36) { const int cn = GD_CHUNK(s + 1);
#pragma unroll
            for (int mt = 0; mt < 4; ++mt) un[mt] = *(const f32x4*)(UB + (size_t)cn * 8192 + ((mt * 8 + n) * 64 + lane) * 4);
            gln = GLB[cn];
            GD_GLDS(cn, (s + 1) & 1); }
        const LAS unsigned char* Bf = lds + (s & 1) * GD_REC + lane * 16;
#define GD_FRAG(f) (*(const LAS bf16x8*)(Bf + (f) * 1024))
        bf16x8 fA[8], fB[8], fC[8];
#define GD_LOAD8(dst, f0) do { _Pragma("unroll") for (int i_ = 0; i_ < 8; ++i_) dst[i_] = GD_FRAG((f0) + i_); } while (0)
#define GD_PIN() __builtin_amdgcn_sched_barrier(0)
        GD_LOAD8(fA, 0); GD_LOAD8(fB, 8);
        bf16x8 Sf[4];
#pragma unroll
        for (int kb = 0; kb < 4; ++kb) Sf[kb] = pack8(S[2 * kb], S[2 * kb + 1]);
        f32x4 O[4];
#pragma unroll
        for (int mt = 0; mt < 4; ++mt) O[mt] = (f32x4){0.f, 0.f, 0.f, 0.f};
        GD_PIN();
#pragma unroll
        for (int i = 0; i < 8; ++i) V[i >> 2] = __builtin_amdgcn_mfma_f32_16x16x32_bf16(fA[i], Sf[i & 3], V[i >> 2], 0, 0, 0);
        GD_PIN(); GD_LOAD8(fC, 16); GD_PIN();
#pragma unroll
        for (int i = 0; i < 8; ++i) V[2 + (i >> 2)] = __builtin_amdgcn_mfma_f32_16x16x32_bf16(fB[i], Sf[i & 3], V[2 + (i >> 2)], 0, 0, 0);
        GD_PIN(); GD_LOAD8(fA, 24); GD_PIN();
#pragma unroll
        for (int i = 0; i < 8; ++i) O[i >> 2] = __builtin_amdgcn_mfma_f32_16x16x32_bf16(fC[i], Sf[i & 3], O[i >> 2], 0, 0, 0);
        GD_PIN(); GD_LOAD8(fB, 32); GD_PIN();
#pragma unroll
        for (int i = 0; i < 8; ++i) O[2 + (i >> 2)] = __builtin_amdgcn_mfma_f32_16x16x32_bf16(fA[i], Sf[i & 3], O[2 + (i >> 2)], 0, 0, 0);
        GD_PIN(); GD_LOAD8(fC, 40); GD_PIN();
        bf16x8 Vf[2]; Vf[0] = pack8(V[0], V[1]); Vf[1] = pack8(V[2], V[3]);
#pragma unroll
        for (int t = 0; t < 8; ++t) S[t] = S[t] * gl;
#pragma unroll
        for (int i = 0; i < 8; ++i) S[i >> 1] = __builtin_amdgcn_mfma_f32_16x16x32_bf16(fB[i], Vf[i & 1], S[i >> 1], 0, 0, 0);
        GD_PIN();
#pragma unroll
        for (int i_ = 0; i_ < 8; ++i_) if (i_ != 1 && i_ != 3) fA[i_] = GD_FRAG(48 + i_);
        GD_PIN();
#pragma unroll
        for (int i = 0; i < 8; ++i) S[4 + (i >> 1)] = __builtin_amdgcn_mfma_f32_16x16x32_bf16(fC[i], Vf[i & 1], S[4 + (i >> 1)], 0, 0, 0);
#pragma unroll
        for (int i = 0; i < 8; ++i) if (i != 1 && i != 3) O[i >> 1] = __builtin_amdgcn_mfma_f32_16x16x32_bf16(fA[i], Vf[i & 1], O[i >> 1], 0, 0, 0);
#undef GD_PIN
#undef GD_LOAD8
#undef GD_FRAG
        if (!(last && c < 4)) {
            LAS unsigned char* ob = ost + (s & 1) * 16384;
            const bool ev = !(cc & 1);
#pragma unroll
            for (int mt = 0; mt < 4; ++mt) {
                const float s0 = ev ? O[mt][2] : O[mt][0], s1 = ev ? O[mt][3] : O[mt][1];
                const float r0 = __builtin_bit_cast(float, __builtin_amdgcn_mov_dpp(__builtin_bit_cast(int, s0), 0xB1, 0xF, 0xF, true));
                const float r1 = __builtin_bit_cast(float, __builtin_amdgcn_mov_dpp(__builtin_bit_cast(int, s1), 0xB1, 0xF, 0xF, true));
                const unsigned w0 = ev ? pk2(O[mt][0], r0) : pk2(r0, O[mt][2]), w1 = ev ? pk2(O[mt][1], r1) : pk2(r1, O[mt][3]);
#pragma unroll
                for (int e = 0; e < 2; ++e) { const int p = 16 * mt + 4 * g + (ev ? 0 : 2) + e, tok = d ? 63 - p : p;
                    *(LAS unsigned*)(ob + tok * 256 + (((2 * n + (cc >> 3)) ^ (((tok >> 2) & 3) << 2)) * 16) + (cc & 6) * 2) = e ? w1 : w0; } }
        }
        cprev = c;
        if (REP_SLEEP) __builtin_amdgcn_s_sleep(REP_SLEEP);
        VM_WAIT(); __syncthreads();
    }
    if (!(last && cprev < 4)) GD_STORE_ROWS(cprev, 35 & 1);
#undef GD_CHUNK
#undef GD_GLDS
#undef GD_STORE_ROWS
}

__device__ __forceinline__ void gdn_out_phase(const Frame& F0, const Args& a0, int l, bool last) {
    const Frame F = relaunder(F0); const Args a = relaunder_args(a0);
    const bf16* GO = (const bf16*)(a.ws + WS_GO2); const bf16* Z = (const bf16*)(a.ws + WS_Z); bf16* MIX = (bf16*)(a.ws + WS_MIX);
    const float* gnorm = a.in[I_GNORM] + l * 128;
    const int gw = F.vcu * NWAVES + F.wave, NGW = F.G * NWAVES;
    f32x4 gn[4];
#pragma unroll
    for (int k = 0; k < 4; ++k) gn[k] = *(const f32x4*)(gnorm + (((F.lane + 64 * k) * 4) & 127));
    for (int m0 = gw; m0 < M; m0 += 2 * NGW) {
        const int m1 = m0 + NGW;
        const bool ok0 = !(last && (m0 % TT) < CTXL), ok1 = m1 < M && !(last && (m1 % TT) < CTXL);
        v2u oa[2][4], ob[2][4], gz[2][4];
#define GO_LOAD(e, m) do { _Pragma("unroll") for (int k = 0; k < 4; ++k) { const int ch = (F.lane + 64 * k) * 4; \
            oa[e][k] = *(const v2u*)(GO + (size_t)(m) * 1024 + ch); ob[e][k] = *(const v2u*)(GO + (size_t)M * 1024 + (size_t)(m) * 1024 + ch); gz[e][k] = *(const v2u*)(Z + (size_t)(m) * ZP + OFF_GATE + ch); } } while (0)
#define GO_ROW(e, m) do { _Pragma("unroll") for (int k = 0; k < 4; ++k) { const int ch = (F.lane + 64 * k) * 4; \
            const f32x4 o = (f32x4){bflo(oa[e][k].x) + bflo(ob[e][k].x), bfhi(oa[e][k].x) + bfhi(ob[e][k].x), bflo(oa[e][k].y) + bflo(ob[e][k].y), bfhi(oa[e][k].y) + bfhi(ob[e][k].y)}; \
            float ss = (o.x * o.x + o.y * o.y) + (o.z * o.z + o.w * o.w); \
            _Pragma("unroll") for (int q = 1; q < 32; q <<= 1) ss += shx(ss, q, F.lane); \
            const float rn = 1.0f / sqrtf(ss * (1.f / 128.f) + EPS); \
            const float g0 = bflo(gz[e][k].x), g1 = bfhi(gz[e][k].x), g2 = bflo(gz[e][k].y), g3 = bfhi(gz[e][k].y); \
            v2u w; w.x = pk2(o.x * rn * gn[k].x * siluf(g0), o.y * rn * gn[k].y * siluf(g1)); \
            w.y = pk2(o.z * rn * gn[k].z * siluf(g2), o.w * rn * gn[k].w * siluf(g3)); \
            *(v2u*)(MIX + (size_t)(m) * 2048 + 1024 + ch) = w; } } while (0)
        if (ok0) GO_LOAD(0, m0);
        if (ok1) GO_LOAD(1, m1);
        __builtin_amdgcn_sched_barrier(0);
        if (ok0) GO_ROW(0, m0);
        if (ok1) GO_ROW(1, m1);
#undef GO_LOAD
#undef GO_ROW
    }
}

__global__ void __launch_bounds__(NTHREADS, 2) fwd(Args args) {
    extern __shared__ __attribute__((aligned(16))) unsigned char lds[];
    Frame F;
    F.lds = (LAS unsigned char*)lds;
    F.wave = __builtin_amdgcn_readfirstlane((int)threadIdx.x >> 6); F.tid = 0; F.lane = 0;
    F.G = gridDim.x; F.bx = blockIdx.x; { const int bx = blockIdx.x; F.vcu = (F.G % 8 == 0) ? (bx % 8) * (F.G / 8) + bx / 8 : bx; }
    unsigned char* ws = args.ws;
    const int lo = args.gp_lo, hi = args.gp_hi;
    for (int u = threadIdx.x; u < (LDS_BYTES - LDSCTL_OFF) / 4; u += NTHREADS) ((LAS unsigned*)(F.lds + LDSCTL_OFF))[u] = 0u;
    __syncthreads();
    XcdBarrier bar = xcd_barrier_post((unsigned*)(ws + WS_CTL) + CW_BAR + args.bar_region * XCD_BAR_WORDS, (volatile LAS unsigned*)(F.lds + MISC_OFF) + 8);
#define IN(g) (lo <= (g) && (g) < hi)
#define SEAM(g) do { if (IN(g) && IN((g) + 1)) xcd_barrier(bar); } while (0)
    if (IN(0)) for (int rep = 0; rep < REP_PRO; ++rep) { p0_prologue(F, args); if (rep + 1 < REP_PRO) xcd_barrier(bar); }
    SEAM(0);
    for (int l = 0; l < DEPTH; ++l) {
        const bool last = (l == DEPTH - 1);
        const float* modl = (const float*)(ws + WS_MOD) + (size_t)l * 5 * D6;
        const float* zmod = (const float*)(ws + WS_ZERO);
        if (IN(GP(l, 0))) for (int rep = 0; rep < REP_NORM; ++rep) { norm_mod_phase(F, args, l, 0, false, (l > 0 && rep == 0) ? modl - 5 * D6 + 3 * D6 + 5 * DM : nullptr); if (REP_NB && rep + 1 < REP_NORM) xcd_barrier(bar); }
        SEAM(GP(l, 0)); if (REP_BAR > 1) SEAM(GP(l, 0));
        if (IN(GP(l, 1))) {
          for (int rep = 0; rep < REP_GEMM * REP_G1; ++rep) {
            unsigned char* ws = relaunder_args(args).ws; const Frame Fg = relaunder(F);
            pg8::Gemm g{(const bf16*)(ws + WS_H), (const bf16*)(ws + WS_WIN) + (size_t)l * D_INP * DM, M, D_INP, DM};
            pg8::Gemm1Order S; S.init(Fg.G, Fg.bx, 0);
            pg8::EpiZ E{(bf16*)(ws + WS_Z), (float*)(ws + WS_AB), (const float*)(ws + WS_ROPE)};
            pg8::gemm_phase<pg8::EpiZ, pg8::Gemm1Order, true, true>(F.lds + RING_OFF, g, S, E, Fg.tid);
            if (rep + 1 < REP_GEMM * REP_G1) xcd_barrier(bar);
          }
        }
        SEAM(GP(l, 1));
        if (IN(GP(l, 2))) for (int rep = 0; rep < REP_MIX * REP_PREP; ++rep) { gdn_prep_phase(F, args, l);
            if (rep == 0 && CV_PREP > 0 && F.vcu >= 128) { __syncthreads(); cv_deferred<2>(F, args, l, 0, CV_PREP, (F.vcu - 128) * NWAVES + F.wave, 128 * NWAVES); }
            if (rep + 1 < REP_MIX * REP_PREP) xcd_barrier(bar); }
        SEAM(GP(l, 2)); if (REP_BAR > 1) SEAM(GP(l, 2));
        if (IN(GP(l, 3))) for (int rep = 0; rep < REP_MIX; ++rep) {
            for (int r2 = 0; r2 < REP_SCAN; ++r2) gdn_scan_phase(F, args, 64, last);
            if (F.bx >= 64 && F.bx < 124) {
                unsigned char* ws = relaunder_args(args).ws; const Frame Fg = relaunder(F);
                pg8::Gemm g{(const bf16*)(ws + WS_H), (const bf16*)(ws + WS_WIN) + (size_t)l * D_INP * DM, M, D_INP, DM};
                pg8::Gemm1Order S; S.init(Fg.G, Fg.bx - 64, 1);
                pg8::EpiZ E{(bf16*)(ws + WS_Z), (float*)(ws + WS_AB), (const float*)(ws + WS_ROPE)};
                pg8::gemm_phase<pg8::EpiZ, pg8::Gemm1Order, true, true>(F.lds + RING_OFF, g, S, E, Fg.tid);
                __syncthreads();
            }
            for (int r2 = 0; r2 < REP_ATTN; ++r2) {
                if (F.bx >= 64 && F.bx < 124) attn_phase(F, args, l, F.bx - 64, 1, 1, 512, 512 + (F.bx - 64), last);
                else if (F.bx >= 124) attn_phase(F, args, l, 60 + (F.bx - 124), 132, 4, 512, F.bx >= 252 ? 572 + (F.bx - 252) : -1, last); }
            if (rep == 0 && CV_P3 > 0 && F.bx >= 180) { __syncthreads(); cv_deferred<2>(F, args, l, CV_PREP, CV_P3, (F.bx - 180) * NWAVES + F.wave, 76 * NWAVES); }
            if (rep + 1 < REP_MIX) xcd_barrier(bar); }
        SEAM(GP(l, 3));
        if (IN(GP(l, 4))) for (int rep = 0; rep < REP_MIX * REP_OUT; ++rep) gdn_out_phase(F, args, l, last);
        SEAM(GP(l, 4)); if (REP_BAR > 1) SEAM(GP(l, 4));
        if (IN(GP(l, 5))) {
          for (int rep = 0; rep < REP_GEMM * REP_G2; ++rep) {
            unsigned char* ws = relaunder_args(args).ws; const Frame Fg = relaunder(F);
            pg8::Gemm g{(const bf16*)(ws + WS_MIX), (const bf16*)(ws + WS_WOUT) + (size_t)l * DM * DM, M, DM, DM};
            pg8::PanelOrder S; S.init2(last ? 32 : 36, DM, DM, Fg.G, Fg.bx, last ? 1 : 0, 8);
            pg8::EpiGate E{(float*)(ws + WS_X), rep ? zmod : modl, 2 * DM, DM / 64, (float*)(ws + WS_SLAB)};
            pg8::gemm_phase<pg8::EpiGate, pg8::PanelOrder, true, true>(F.lds + RING_OFF, g, S, E, Fg.tid);
            if (rep + 1 < REP_GEMM * REP_G2) xcd_barrier(bar);
          }
        }
        SEAM(GP(l, 5));
        if (IN(GP(l, 6))) for (int rep = 0; rep < REP_NORM; ++rep) norm_mod_phase(F, args, l, 1, last, (last || rep) ? nullptr : modl + 3 * D6 + 2 * DM);
        SEAM(GP(l, 6)); if (REP_BAR > 1) SEAM(GP(l, 6));
        if (IN(GP(l, 7))) {
          for (int rep = 0; rep < REP_GEMM * REP_G3; ++rep) {
            unsigned char* ws = relaunder_args(args).ws; const Frame Fg = relaunder(F);
            pg8::Gemm g{(const bf16*)(ws + WS_H), (const bf16*)(ws + WS_W1) + (size_t)l * DFF * DM, M, DFF, DM};
            pg8::PanelOrder S; S.init2(last ? 32 : 36, DFF, DM, Fg.G, Fg.bx, last ? 1 : 0, 1); S.consttile = (rep > 0) ? REP_CT : 0;
            pg8::EpiSq E{(bf16*)(ws + (rep > 0 && REP_CT ? WS_GQ : WS_FFH)), DFF};
            if (rep > 0 && REP_CT == 2) { g.K = DM; S.ntk = 16; }
            pg8::gemm_phase<pg8::EpiSq, pg8::PanelOrder, true, true>(F.lds + RING_OFF, g, S, E, Fg.tid);
            if (!last && rep == 0 && CV_DEFER > 0 && F.bx >= 128) { __syncthreads(); cv_deferred<1>(F, args, l + 1, 0, CV_DEFER, (F.bx - 128) * NWAVES + F.wave, 128 * NWAVES); }
            if (rep + 1 < REP_GEMM * REP_G3) xcd_barrier(bar);
          }
        }
        SEAM(GP(l, 7));
        if (IN(GP(l, 8))) {
          for (int rep = 0; rep < REP_GEMM * REP_G4; ++rep) {
            unsigned char* ws = relaunder_args(args).ws; const Frame Fg = relaunder(F);
            pg8::Gemm g{(const bf16*)(ws + WS_FFH), (const bf16*)(ws + WS_W2) + (size_t)l * DM * DFF, M, DM, DFF};
            pg8::PanelOrder S; S.init2(last ? 32 : 36, DM, DFF, Fg.G, Fg.bx, last ? 1 : 0, 8);
            pg8::EpiGate E{(float*)(ws + WS_X), rep ? zmod : modl, 5 * DM, DFF / 64, (float*)(ws + WS_SLAB)};
            pg8::gemm_phase<pg8::EpiGate, pg8::PanelOrder, true, true>(F.lds + RING_OFF, g, S, E, Fg.tid);
            if (rep + 1 < REP_GEMM * REP_G4) xcd_barrier(bar);
          }
        }
        SEAM(GP(l, 8));
    }
    if (IN(GP_FINAL)) for (int rep = 0; rep < REP_FIN; ++rep) final_norm_phase(F, args);
#undef IN
#undef SEAM
}

static void launch_fwd(const Args& base, int lo, int hi, int region, int grid, hipStream_t stream) {
    Args a = base; a.gp_lo = lo; a.gp_hi = hi; a.bar_region = region;
    hipLaunchKernelGGL(fwd, dim3(grid), dim3(NTHREADS), LDS_BYTES, stream, a);
}
extern "C" void kernel_launch(void* const* d_in, const int* in_sizes, int n_in, void* d_out, int out_size, void* d_ws, size_t ws_size, hipStream_t stream) {
    static int grid = 0;
    if (grid == 0) {
        if (n_in != 18 || out_size != NB * SEQ * DM || ws_size < WS_END) { fprintf(stderr, "kernel_launch: unexpected shapes (n_in %d out %d ws %zu)\n", n_in, out_size, ws_size); grid = -1; return; }
        int dev = 0, cus = 0;
        if (hipGetDevice(&dev) != hipSuccess || hipDeviceGetAttribute(&cus, hipDeviceAttributeMultiprocessorCount, dev) != hipSuccess) { grid = -1; return; }
        if (hipFuncSetAttribute((const void*)fwd, hipFuncAttributeMaxDynamicSharedMemorySize, LDS_BYTES) != hipSuccess) { fprintf(stderr, "kernel_launch: hipFuncSetAttribute failed\n"); grid = -1; return; }
        (void)hipGetLastError();
        grid = cus;
    }
    if (grid < 0) return;
    unsigned char* ws = (unsigned char*)d_ws;
    (void)hipMemsetAsync(ws + WS_CTL, 0, CTL_ZERO_BYTES, stream);
    if (REP_GEMM * REP_G2 * REP_G4 > 1) (void)hipMemsetAsync(ws + WS_ZERO, 0, 1 * MiB, stream);
    Args a{};
    for (int i = 0; i < 18; ++i) a.in[i] = (const float*)d_in[i];
    a.out = (float*)d_out; a.ws = ws;
    launch_fwd(a, 0, GP_FINAL + 1, 0, grid, stream);
}
```

```cpp
#include <hip/hip_runtime.h>
#include <cstdio>
#include <cstdint>
#include <utility>

constexpr int DM = 2048, NB = 4, SEQ = 2048, DEPTH = 4, CTXL = 256, DH = 128;
constexpr int TT = CTXL + SEQ;
constexpr int M = NB * TT;
constexpr int D_IN = 5664, D_INP = 5888, ZP = 5632, DFF = 8192, D6 = 6 * DM;
constexpr int OFF_AQ = 0, OFF_AK = 1024, OFF_AV = 1280, OFF_GQKV = 1536, OFF_GATE = 4608;
constexpr float EPS = 1e-6f;

constexpr size_t MiB = 1u << 20;
constexpr size_t WS_CTL = 0, CTL_ZERO_BYTES = 1 * MiB;
constexpr size_t WS_MOD = 1 * MiB;
constexpr size_t WS_ROPE = 2 * MiB;
constexpr size_t WS_WIN = 4 * MiB;
constexpr size_t WS_WOUT = 96 * MiB;
constexpr size_t WS_W1 = 128 * MiB;
constexpr size_t WS_W2 = 256 * MiB;
constexpr size_t WS_X = 384 * MiB;
constexpr size_t WS_H = 456 * MiB;
constexpr size_t WS_Z = 492 * MiB;
constexpr size_t WS_AB = 596 * MiB;
constexpr size_t WS_MIX = 598 * MiB;
constexpr size_t WS_FFH = 634 * MiB;
constexpr size_t WS_GQ = 778 * MiB;
constexpr size_t WS_GK = 814 * MiB;
constexpr size_t WS_GV = 850 * MiB;
constexpr size_t WS_GG = 886 * MiB;
constexpr size_t WS_GB = 887 * MiB;
constexpr size_t WS_GO = 888 * MiB;
constexpr size_t WS_AQ = 960 * MiB;
constexpr size_t WS_AK = 996 * MiB;
constexpr size_t WS_GREC = 1008 * MiB;
constexpr size_t WS_GU = 1134 * MiB;
constexpr size_t WS_GL = 1206 * MiB;
constexpr size_t WS_GO2 = 1208 * MiB;
constexpr size_t WS_SLAB = 1280 * MiB;
constexpr size_t WS_ZERO = 1344 * MiB;
constexpr size_t WS_END = 1346 * MiB;

constexpr int NWAVES = 8, NTHREADS = 512;
constexpr int RING_OFF = 0, RING_BYTES = 147456, LDSCTL_OFF = RING_BYTES, MISC_OFF = LDSCTL_OFF + 320;
constexpr int LDS_BYTES = RING_BYTES + 2048;

#define GAS __attribute__((address_space(1)))
#define LAS __attribute__((address_space(3)))
typedef unsigned short bf16;
typedef unsigned v4u __attribute__((ext_vector_type(4)));
typedef unsigned v2u __attribute__((ext_vector_type(2)));
typedef float f32x4 __attribute__((ext_vector_type(4)));
#define LDS_WAIT() asm volatile("s_waitcnt lgkmcnt(0)" ::: "memory")
#define VM_WAIT() asm volatile("s_waitcnt vmcnt(0)" ::: "memory")
#define LDS_BARRIER() asm volatile("s_waitcnt lgkmcnt(0)\n\ts_barrier" ::: "memory")
__device__ __forceinline__ unsigned f2bf(float f) { unsigned u = __builtin_bit_cast(unsigned, f); return (u + 0x7fffu + ((u >> 16) & 1u)) >> 16; }
typedef __bf16 bf16x2p __attribute__((ext_vector_type(2)));
typedef float f32x2p __attribute__((ext_vector_type(2)));
__device__ __forceinline__ unsigned pk2(float lo, float hi) { return __builtin_bit_cast(unsigned, __builtin_convertvector((f32x2p){lo, hi}, bf16x2p)); }
__device__ __forceinline__ float bf2f(unsigned short b) { return __builtin_bit_cast(float, (unsigned)b << 16); }
__device__ __forceinline__ float bflo(unsigned w) { return __builtin_bit_cast(float, w << 16); }
__device__ __forceinline__ float bfhi(unsigned w) { return __builtin_bit_cast(float, w & 0xffff0000u); }
__device__ __forceinline__ float shx(float v, int m, int lane) { return __builtin_bit_cast(float, __builtin_amdgcn_ds_bpermute((lane ^ m) << 2, __builtin_bit_cast(int, v))); }
__device__ __forceinline__ float wave_sum(float v, int lane) {
#pragma unroll
    for (int o = 1; o < 64; o <<= 1) v += shx(v, o, lane);
    return v;
}
__device__ __forceinline__ float siluf(float v) { return v / (1.f + __expf(-v)); }

namespace pg8 {
#define PG8_LAS __attribute__((address_space(3)))
typedef unsigned short bf16_t;
typedef short bf16x8 __attribute__((ext_vector_type(8)));
typedef float f32x4 __attribute__((ext_vector_type(4)));
typedef unsigned u32x4 __attribute__((ext_vector_type(4)));
constexpr int BM = 256, BK = 64, HALF = 128, HTB = HALF * BK * 2  , STAGE_BYTES = 8 * HTB, NXCD = 8, WGM = 8;

__host__ __device__ __forceinline__ int lds_byte(int r, int c) { const int st = (r >> 4) * 2 + (c >> 5), rr = r & 15, cc = c & 31, ob = rr * 64 + cc * 2; return st * 1024 + (ob ^ (((ob >> 9) & 1) << 5)); }
__host__ __device__ __forceinline__ void stage_rc(int b, int& R, int& C) { const int st = b / 1024, sb = b % 1024, swz = sb ^ (((sb >> 9) & 1) << 5); R = (st >> 1) * 16 + swz / 64; C = (st & 1) * 32 + (swz % 64) / 2; }
__host__ __device__ __forceinline__ int perm32(int rho) { const int n = rho >> 4, i = rho & 15; return 8 * (i >> 2) + 4 * n + (i & 3); }

struct Unit { int pm, pn, kofs, nt; };
struct Gemm { const bf16_t* A; const bf16_t* Bt; int M, N, K; };

struct StaticOrder {
    int nM, nN, nwg, G, c;
    __host__ __device__ void init(int M, int N, int G_, int c_) { nM = M / BM; nN = N / BM; nwg = nM * nN; G = G_; c = c_; }
    __host__ __device__ bool next(int i, Unit& u) const {
        const long L = (long)i * G + c; if (L >= nwg) return false;
        int wgid = (int)L; { const int q = nwg / NXCD, r = nwg % NXCD, xcd = wgid % NXCD, off = wgid / NXCD; wgid = (xcd < r ? xcd * (q + 1) : r * (q + 1) + (xcd - r) * q) + off; }
        const int nig = WGM * nN, gid = wgid / nig, fm = gid * WGM, gsz = (nM - fm) < WGM ? (nM - fm) : WGM;
        u.pm = fm + ((wgid % nig) % gsz); u.pn = (wgid % nig) / gsz; return true;
    }
    __device__ __forceinline__ void a_ready(const Unit&) const {}
    __device__ __forceinline__ void done(const Unit&) const {}
};

typedef __bf16 bf16x2c __attribute__((ext_vector_type(2)));
typedef float f32x2c __attribute__((ext_vector_type(2)));
__device__ __forceinline__ unsigned cvt_pk_bf16(float lo, float hi) { return __builtin_bit_cast(unsigned, __builtin_convertvector((f32x2c){lo, hi}, bf16x2c)); }
typedef float f32x2 __attribute__((ext_vector_type(2)));

typedef unsigned u32x4 __attribute__((ext_vector_type(4)));
struct PanelOrder : StaticOrder {
    int skip_ctx, ntk, ksplit, nfull, nMall, consttile = 0;
    __device__ void init2(int nMc, int N, int K, int G_, int c_, int skip, int ksplit_) { nN = N / BM; G = G_; c = c_; skip_ctx = skip; ntk = K / BK; ksplit = ksplit_; nMall = nMc;
        nfull = (ksplit_ > 1) ? ((nMc * nN) / G_) * G_ : nMc * nN; nM = nfull / nN; nwg = nfull; }
    __device__ bool next(int i, Unit& u) const {
        const long L = (long)i * G + c;
        if (L < nfull) { if (!StaticOrder::next(i, u)) return false; u.nt = ntk; u.kofs = 0; }
        else { const long s = L - nfull; const int t = (int)(s / ksplit), ks = (int)(s % ksplit); u.pm = nM + t / nN; u.pn = t % nN; if (u.pm >= nMall) return false;
            u.nt = ntk / ksplit; u.kofs = ks * u.nt * (BK * 2); }
        if (skip_ctx) u.pm = u.pm + (u.pm >> 3) + 1;
        if (consttile) { u.pm = 1; u.pn = 0; }
        return true;
    }
};

struct Gemm1Order {
    int G, c, mode;
    __device__ void init(int G_, int c_, int mode_) { G = G_; c = c_; mode = mode_; }
    __device__ bool next(int i, Unit& u) const {
        u.nt = 32; u.kofs = 0;
        if (mode == 1) { if (i != 0 || c < 0 || c >= 60) return false; u.pm = 21 + (c >> 2); u.pn = 18 + (c & 3); return true; }
        const int L = i * G + c;
        if (L < 684) {
            constexpr int nM = 36, nN = 19, nwg = nM * nN;
            int wgid = L; { const int q = nwg / NXCD, r = nwg % NXCD, xcd = wgid % NXCD, off = wgid / NXCD; wgid = (xcd < r ? xcd * (q + 1) : r * (q + 1) + (xcd - r) * q) + off; }
            const int nig = WGM * nN, gid = wgid / nig, fm = gid * WGM, gsz = (nM - fm) < WGM ? (nM - fm) : WGM;
            u.pm = fm + ((wgid % nig) % gsz); const int pn = (wgid % nig) / gsz; u.pn = pn < 18 ? pn : 22; return true; }
        if (L < 768) { const int idx = L - 684; u.pm = idx >> 2; u.pn = 18 + (idx & 3); return true; }
        return false;
    }
    __device__ __forceinline__ void a_ready(const Unit&) const {}
    __device__ __forceinline__ void done(const Unit&) const {}
};

struct EpiZ {
    static constexpr bool PERM = true, AFTER_DRAIN = false;
    bf16_t* Z; float* AB; const float* rope;
    __device__ __forceinline__ void operator()(const f32x4 (&acc)[2][2][4][2], const Unit& u, int wr, int wc, int fr, int fq) const {
        const int row0 = u.pm * BM + wr * 64 + fr;
        if (u.pn == 22) {
            if (wc == 0) {
#pragma unroll
                for (int ai = 0; ai < 2; ++ai)
#pragma unroll
                    for (int m = 0; m < 4; ++m) { float* rp = AB + (size_t)(row0 + ai * HALF + m * 16) * 32 + 8 * fq;
                        *(f32x4*)(rp) = acc[ai][0][m][0]; *(f32x4*)(rp + 4) = acc[ai][0][m][1]; }
            }
        } else {
            const int col0 = u.pn * BM + wc * 32 + 8 * fq;
            const int pb = u.pm / 9; const bool dorope = (u.pn < 5) && (u.pm - 9 * pb != 0);
            const int tl0 = (u.pm - 9 * pb - 1) * BM + wr * 64 + fr;
#pragma unroll
            for (int ai = 0; ai < 2; ++ai) {
                f32x4 csv[4], snv[4];
                if (dorope) {
#pragma unroll
                    for (int m = 0; m < 4; ++m) { const int tl = tl0 + ai * HALF + m * 16, c = col0, half = (c >> 6) & 1, i0 = (c & 63) >> 1, pe = half ? 32 + (tl & 63) : (tl >> 6);
                        csv[m] = *(const f32x4*)(rope + pe * 32 + i0); snv[m] = *(const f32x4*)(rope + 96 * 32 + pe * 32 + i0); }
                    __builtin_amdgcn_sched_barrier(0); }
#pragma unroll
                for (int m = 0; m < 4; ++m) { bf16_t* rowp = Z + (size_t)(row0 + ai * HALF + m * 16) * 5632 + col0;
#pragma unroll
                    for (int bj = 0; bj < 2; ++bj) { f32x4 v0 = acc[ai][bj][m][0], v1 = acc[ai][bj][m][1];
                        if (dorope) { const f32x4 cs = csv[m], sn = snv[m];
                            const f32x4 a0 = v0, a1 = v1;
                            v0[0] = a0[0] * cs[0] - a0[1] * sn[0]; v0[1] = a0[1] * cs[0] + a0[0] * sn[0];
                            v0[2] = a0[2] * cs[1] - a0[3] * sn[1]; v0[3] = a0[3] * cs[1] + a0[2] * sn[1];
                            v1[0] = a1[0] * cs[2] - a1[1] * sn[2]; v1[1] = a1[1] * cs[2] + a1[0] * sn[2];
                            v1[2] = a1[2] * cs[3] - a1[3] * sn[3]; v1[3] = a1[3] * cs[3] + a1[2] * sn[3]; }
                        u32x4 w; w.x = cvt_pk_bf16(v0[0], v0[1]); w.y = cvt_pk_bf16(v0[2], v0[3]); w.z = cvt_pk_bf16(v1[0], v1[1]); w.w = cvt_pk_bf16(v1[2], v1[3]);
                        *(u32x4*)(rowp + bj * HALF) = w; } } }
        }
    }
};
struct EpiSq {
    static constexpr bool PERM = true, AFTER_DRAIN = false;
    bf16_t* O; int ldc;
    __device__ __forceinline__ void operator()(const f32x4 (&acc)[2][2][4][2], const Unit& u, int wr, int wc, int fr, int fq) const {
        const int row0 = u.pm * BM + wr * 64 + fr, col0 = u.pn * BM + wc * 32 + 8 * fq;
#pragma unroll
        for (int ai = 0; ai < 2; ++ai)
#pragma unroll
            for (int m = 0; m < 4; ++m) { bf16_t* rowp = O + (size_t)(row0 + ai * HALF + m * 16) * ldc + col0;
#pragma unroll
                for (int bj = 0; bj < 2; ++bj) { f32x4 v0 = acc[ai][bj][m][0], v1 = acc[ai][bj][m][1];
#pragma unroll
                    for (int j = 0; j < 4; ++j) { const float x0 = v0[j], x1 = v1[j]; const int i0 = __builtin_bit_cast(int, x0), i1 = __builtin_bit_cast(int, x1);
                        const float a = __builtin_bit_cast(float, i0 > 0 ? i0 : 0), b = __builtin_bit_cast(float, i1 > 0 ? i1 : 0); v0[j] = a * a; v1[j] = b * b; }
                    u32x4 w; w.x = cvt_pk_bf16(v0[0], v0[1]); w.y = cvt_pk_bf16(v0[2], v0[3]); w.z = cvt_pk_bf16(v1[0], v1[1]); w.w = cvt_pk_bf16(v1[2], v1[3]);
                    *(u32x4*)(rowp + bj * HALF) = w; } }
    }
};
struct EpiGate {
    static constexpr bool PERM = false, AFTER_DRAIN = false;
    float* X; const float* modl; int goff, ntfull; float* slab;
    __device__ __forceinline__ void operator()(const f32x4 (&acc)[2][2][4][2], const Unit& u, int wr, int wc, int fr, int fq) const {
        const int row0 = u.pm * BM + wr * 64 + fr, col0 = u.pn * BM + wc * 32 + 4 * fq;
        if (u.nt != ntfull) {
            const int ks = u.kofs / (u.nt * (BK * 2));
            float* base = slab + ((size_t)ks * 1024 + (row0 - 8192)) * 2048 + col0;
#pragma unroll
            for (int ai = 0; ai < 2; ++ai)
#pragma unroll
                for (int m = 0; m < 4; ++m) { float* rowp = base + (size_t)(ai * HALF + m * 16) * 2048;
#pragma unroll
                    for (int bj = 0; bj < 2; ++bj)
#pragma unroll
                        for (int n = 0; n < 2; ++n) *(f32x4*)(rowp + bj * HALF + n * 16) = acc[ai][bj][m][n]; }
            return;
        }
        const int b = u.pm / 9, r = (u.pm - 9 * b == 0) ? 4 : b;
        const float* gate = modl + (size_t)r * 12288 + goff;
        f32x4 gv[2][2];
#pragma unroll
        for (int bj = 0; bj < 2; ++bj)
#pragma unroll
            for (int n = 0; n < 2; ++n) gv[bj][n] = *(const f32x4*)(gate + col0 + bj * HALF + n * 16);
#pragma unroll
        for (int ai = 0; ai < 2; ++ai)
#pragma unroll
            for (int mp = 0; mp < 2; ++mp) { float* rowp = X + (size_t)(row0 + ai * HALF + mp * 32) * 2048 + col0;
                f32x4 xv[2][2][2];
#pragma unroll
                for (int mm = 0; mm < 2; ++mm)
#pragma unroll
                    for (int bj = 0; bj < 2; ++bj)
#pragma unroll
                        for (int n = 0; n < 2; ++n) xv[mm][bj][n] = *(const f32x4*)(rowp + (size_t)mm * 16 * 2048 + bj * HALF + n * 16);
                __builtin_amdgcn_sched_barrier(0);
#pragma unroll
                for (int mm = 0; mm < 2; ++mm)
#pragma unroll
                    for (int bj = 0; bj < 2; ++bj)
#pragma unroll
                        for (int n = 0; n < 2; ++n) *(f32x4*)(rowp + (size_t)mm * 16 * 2048 + bj * HALF + n * 16) = xv[mm][bj][n] + gv[bj][n] * acc[ai][bj][2 * mp + mm][n];
                __builtin_amdgcn_sched_barrier(0); }
    }
};

template <class Epi, class Sched, bool ALIGN_EPI = false, bool SP2 = false>
__device__ __forceinline__ void gemm_phase(PG8_LAS unsigned char* lds, const Gemm g, const Sched& S, const Epi& E, const int tid_l) {
    const int tid = tid_l, wid = __builtin_amdgcn_readfirstlane(tid >> 6), lane = tid & 63, wr = wid >> 2, wc = wid & 3, fr = lane & 15, fq = lane >> 4;
    const int K = g.K;
    unsigned voffA[2], voffB[2];
#pragma unroll
    for (int i = 0; i < 2; ++i) { int R, C; stage_rc(tid * 16 + i * 8192, R, C); const int Rb = Epi::PERM ? ((R & ~31) + perm32(R & 31)) : R;
        voffA[i] = (unsigned)(R * K + C) * 2u; voffB[i] = (unsigned)(Rb * K + C) * 2u; }
    const size_t kstep = (size_t)(BK * 2);
    const size_t hstep = (size_t)HALF * K * 2;
    const size_t tstep = 2 * hstep;
    const unsigned ldsw = (unsigned)wid * 1024u;
    const int aoff = lds_byte(wr * 64 + fr, fq * 8), boff = lds_byte(wc * 32 + fr, fq * 8);
#define PG8_SA(b, h) (((b) * 2 + (h)) * HTB)
#define PG8_SB(b, h) ((4 + (b) * 2 + (h)) * HTB)
#define PG8_STAGE(bufoff, gbase, voff) do { const char* _gb = (const char*)(gbase); asm volatile("" : "+s"(_gb)); _Pragma("unroll") for (int _i = 0; _i < 2; ++_i) { \
        unsigned _vo = (voff)[_i]; asm volatile("" : "+v"(_vo)); \
        __builtin_amdgcn_global_load_lds((const unsigned*)(_gb + _vo), (PG8_LAS unsigned*)(lds + (bufoff) + ldsw + _i * 8192), 16, 0, 0); } } while (0)
#define PG8_LDA(dst, b, h) do { _Pragma("unroll") for (int m = 0; m < 4; ++m) _Pragma("unroll") for (int k = 0; k < 2; ++k) dst[m][k] = *(const PG8_LAS bf16x8*)(lds + PG8_SA(b, h) + aoff + m * 2048 + k * 1024); } while (0)
#define PG8_LDB(dst, b, h) do { _Pragma("unroll") for (int n = 0; n < 2; ++n) _Pragma("unroll") for (int k = 0; k < 2; ++k) dst[n][k] = *(const PG8_LAS bf16x8*)(lds + PG8_SB(b, h) + boff + n * 2048 + k * 1024); } while (0)
#define PG8_MMA(ai, bj, At, Bt) do { __builtin_amdgcn_s_setprio(1); _Pragma("unroll") for (int m = 0; m < 4; ++m) _Pragma("unroll") for (int n = 0; n < 2; ++n) _Pragma("unroll") for (int k = 0; k < 2; ++k) \
        acc[ai][bj][m][n] = __builtin_amdgcn_mfma_f32_16x16x32_bf16(Bt[n][k], At[m][k], acc[ai][bj][m][n], 0, 0, 0); __builtin_amdgcn_s_setprio(0); } while (0)
#define PG8_WAIT_V(n) asm volatile("s_waitcnt vmcnt(" #n ")" ::: "memory")
#define PG8_WAIT_L(n) asm volatile("s_waitcnt lgkmcnt(" #n ")" ::: "memory")
#define PG8_BAR __builtin_amdgcn_s_barrier()
#define PG8_SCHED __builtin_amdgcn_sched_barrier(0)
    Unit cur, nxt; int ui = 0;
    if (!S.next(0, cur)) return;
    f32x4 acc[2][2][4][2];
#pragma unroll
    for (int a = 0; a < 2; ++a)
#pragma unroll
        for (int b = 0; b < 2; ++b)
#pragma unroll
            for (int m = 0; m < 4; ++m)
#pragma unroll
                for (int n = 0; n < 2; ++n) acc[a][b][m][n] = (f32x4){0.f, 0.f, 0.f, 0.f};
    bf16x8 At[4][2], B0[2][2], B1[2][2];
    const char* cA = (const char*)g.A + (size_t)cur.pm * tstep + cur.kofs; const char* cB = (const char*)g.Bt + (size_t)cur.pn * tstep + cur.kofs;
    S.a_ready(cur);
    if constexpr (SP2) {
        PG8_STAGE(PG8_SB(0, 0), cB, voffB); PG8_STAGE(PG8_SB(0, 1), cB + hstep, voffB); PG8_STAGE(PG8_SA(0, 0), cA, voffA); PG8_STAGE(PG8_SA(0, 1), cA + hstep, voffA);
        if (wr == 1) PG8_BAR;
        PG8_WAIT_V(2); PG8_BAR;
        PG8_STAGE(PG8_SB(1, 0), cB + kstep, voffB); PG8_STAGE(PG8_SA(1, 0), cA + kstep, voffA); PG8_STAGE(PG8_SB(1, 1), cB + hstep + kstep, voffB);
        PG8_WAIT_V(6); PG8_BAR;
    } else {
        PG8_STAGE(PG8_SB(0, 0), cB, voffB); PG8_STAGE(PG8_SA(0, 0), cA, voffA); PG8_STAGE(PG8_SB(0, 1), cB + hstep, voffB); PG8_STAGE(PG8_SA(0, 1), cA + hstep, voffA);
        if (wr == 1) PG8_BAR;
        PG8_WAIT_V(4); PG8_BAR;
        PG8_STAGE(PG8_SB(1, 0), cB + kstep, voffB); PG8_STAGE(PG8_SA(1, 0), cA + kstep, voffA); PG8_STAGE(PG8_SB(1, 1), cB + hstep + kstep, voffB);
        PG8_WAIT_V(6); PG8_BAR;
    }
    for (;;) {
        const bool has_next = S.next(ui + 1, nxt);
        const char* nA = has_next ? (const char*)g.A + (size_t)nxt.pm * tstep + nxt.kofs : cA; const char* nB = has_next ? (const char*)g.Bt + (size_t)nxt.pn * tstep + nxt.kofs : cB;
        const int nt = cur.nt;
        for (int t = 0; t < nt; t += 2) {
            const bool last = (t == nt - 2);
            const char* a1 = cA + (size_t)(t + 1) * kstep;
            const char* a2 = last ? nA : cA + (size_t)(t + 2) * kstep; const char* b2 = last ? nB : cB + (size_t)(t + 2) * kstep;
            const char* a3 = a2 + kstep; const char* b3 = b2 + kstep;
            if (last && has_next) S.a_ready(nxt);
            if constexpr (SP2) {
            PG8_LDB(B0, 0, 0); PG8_LDB(B1, 0, 1); PG8_SCHED; PG8_LDA(At, 0, 0); PG8_STAGE(PG8_SA(1, 1), a1 + hstep, voffA);
            PG8_WAIT_V(8); PG8_WAIT_L(0); PG8_BAR; PG8_MMA(0, 0, At, B0); PG8_MMA(0, 1, At, B1); PG8_BAR; PG8_SCHED;
            PG8_LDA(At, 0, 1); PG8_STAGE(PG8_SB(0, 0), b2, voffB); PG8_STAGE(PG8_SB(0, 1), b2 + hstep, voffB); PG8_STAGE(PG8_SA(0, 0), a2, voffA);
            PG8_WAIT_V(8); PG8_WAIT_L(0); PG8_BAR; PG8_MMA(1, 0, At, B0); PG8_MMA(1, 1, At, B1); PG8_BAR; PG8_SCHED;
            PG8_LDB(B0, 1, 0); PG8_LDB(B1, 1, 1); PG8_SCHED; PG8_LDA(At, 1, 0); PG8_STAGE(PG8_SA(0, 1), a2 + hstep, voffA);
            PG8_WAIT_V(8); PG8_WAIT_L(0); PG8_BAR; PG8_MMA(0, 0, At, B0); PG8_MMA(0, 1, At, B1); PG8_BAR; PG8_SCHED;
            PG8_LDA(At, 1, 1); PG8_STAGE(PG8_SB(1, 0), b3, voffB); PG8_STAGE(PG8_SB(1, 1), b3 + hstep, voffB); PG8_STAGE(PG8_SA(1, 0), a3, voffA);
            PG8_WAIT_V(8); PG8_WAIT_L(0); PG8_BAR; PG8_MMA(1, 0, At, B0); PG8_MMA(1, 1, At, B1); PG8_BAR; PG8_SCHED;
            } else {
            PG8_LDB(B0, 0, 0); PG8_SCHED; PG8_LDA(At, 0, 0); PG8_STAGE(PG8_SA(1, 1), a1 + hstep, voffA);
            PG8_WAIT_L(8); PG8_BAR; PG8_WAIT_L(0); PG8_MMA(0, 0, At, B0); PG8_BAR; PG8_SCHED;
            PG8_LDB(B1, 0, 1); PG8_STAGE(PG8_SB(0, 0), b2, voffB);
            PG8_BAR; PG8_WAIT_L(0); PG8_MMA(0, 1, At, B1); PG8_BAR;
            PG8_LDA(At, 0, 1); PG8_STAGE(PG8_SA(0, 0), a2, voffA);
            PG8_BAR; PG8_WAIT_L(0); PG8_MMA(1, 0, At, B0); PG8_BAR; PG8_SCHED;
            PG8_STAGE(PG8_SB(0, 1), b2 + hstep, voffB);
            PG8_WAIT_V(6); PG8_BAR; PG8_MMA(1, 1, At, B1); PG8_BAR;
            PG8_LDB(B0, 1, 0); PG8_SCHED; PG8_LDA(At, 1, 0); PG8_STAGE(PG8_SA(0, 1), a2 + hstep, voffA);
            PG8_WAIT_L(8); PG8_BAR; PG8_WAIT_L(0); PG8_MMA(0, 0, At, B0); PG8_BAR; PG8_SCHED;
            PG8_LDB(B1, 1, 1); PG8_STAGE(PG8_SB(1, 0), b3, voffB);
            PG8_BAR; PG8_WAIT_L(0); PG8_MMA(0, 1, At, B1); PG8_BAR;
            PG8_LDA(At, 1, 1); PG8_STAGE(PG8_SA(1, 0), a3, voffA);
            PG8_BAR; PG8_WAIT_L(0); PG8_MMA(1, 0, At, B0); PG8_BAR; PG8_SCHED;
            PG8_STAGE(PG8_SB(1, 1), b3 + hstep, voffB);
            PG8_WAIT_V(6); PG8_BAR; PG8_MMA(1, 1, At, B1); PG8_BAR;
            }
        }
        if constexpr (ALIGN_EPI) { if (wr == 0) PG8_BAR; }
        if constexpr (!Epi::AFTER_DRAIN) { int frl = fr, fql = fq; asm volatile("" : "+v"(frl), "+v"(fql));
            E(acc, cur, wr, wc, frl, fql); S.done(cur); }
        if (!has_next) break;
#pragma unroll
        for (int a = 0; a < 2; ++a)
#pragma unroll
            for (int b = 0; b < 2; ++b)
#pragma unroll
                for (int m = 0; m < 4; ++m)
#pragma unroll
                    for (int n = 0; n < 2; ++n) acc[a][b][m][n] = (f32x4){0.f, 0.f, 0.f, 0.f};
        cur = nxt; cA = nA; cB = nB; ++ui;
        if constexpr (ALIGN_EPI) { if (wr == 1) PG8_BAR; }
    }
    PG8_WAIT_V(0);
    if constexpr (!ALIGN_EPI) { if (wr == 0) PG8_BAR; }
    PG8_BAR;
    if constexpr (Epi::AFTER_DRAIN) { E.fused(acc, cur, wr, wc, fr, fq, lds, wid, lane); S.done(cur); }
#undef PG8_SA
#undef PG8_SB
#undef PG8_STAGE
#undef PG8_LDA
#undef PG8_LDB
#undef PG8_MMA
#undef PG8_WAIT_V
#undef PG8_WAIT_L
#undef PG8_BAR
#undef PG8_SCHED
}
}

#define XB_TMO      128
#define XB_XCNT(j)  (256  + 64 * (j))
#define XB_XSUB(j)  (1280 + 64 * (j))
#define XB_XGEN(j)  (2304 + 64 * (j))
#define XB_TOP      3328
#define XB_TOPGEN   3392
#define XCD_BAR_WORDS 3456
#define XB_SPIN_CAP (1u << 18)

__device__ __forceinline__ unsigned xb_ld(unsigned* p)              { return __hip_atomic_load(p, __ATOMIC_RELAXED, __HIP_MEMORY_SCOPE_AGENT); }
__device__ __forceinline__ unsigned xb_add(unsigned* p, unsigned v) { return __hip_atomic_fetch_add(p, v, __ATOMIC_RELAXED, __HIP_MEMORY_SCOPE_AGENT); }
__device__ __forceinline__ unsigned xb_xcc_id() { return (unsigned)__builtin_amdgcn_s_getreg((3 << 11) | 20) & 0xFu; }
#define XB_SPIN(cond, bar) do { unsigned _sp = 0; while (cond) { __builtin_amdgcn_s_sleep(1); \
    if ((++_sp & 255u) == 0u) { if (xb_ld(&(bar)[XB_TMO])) break; if (_sp > XB_SPIN_CAP) { atomicAdd(&(bar)[XB_TMO], 1u); break; } } } } while (0)

struct XcdBarrier {
    unsigned* bar; unsigned x;
    volatile LAS unsigned* st;
};

__device__ __forceinline__ XcdBarrier xcd_barrier_post(unsigned* bar, volatile LAS unsigned* st) {
    XcdBarrier b; b.bar = bar; b.x = xb_xcc_id(); b.st = st;
    if (threadIdx.x == 0) (void)xb_add(&bar[XB_XCNT(b.x)], 1u);
    return b;
}
__device__ __forceinline__ void xcd_barrier_complete(unsigned* bar, unsigned x, unsigned& nloc, unsigned& nx) {
    const unsigned G = gridDim.x * gridDim.y * gridDim.z;
    unsigned sum, cnt, mine, sp = 0u;
    for (;;) {
        sum = 0u; cnt = 0u; mine = 0u;
#pragma unroll 1
        for (unsigned j = 0; j < 16; ++j) { const unsigned c = xb_ld(&bar[XB_XCNT(j)]); sum += c; cnt += (c > 0u) ? 1u : 0u; mine = (j == x) ? c : mine; }
        if (sum == G) break;
        __builtin_amdgcn_s_sleep(1);
        if ((++sp & 255u) == 0u) { if (xb_ld(&bar[XB_TMO])) break; if (sp > XB_SPIN_CAP) { atomicAdd(&bar[XB_TMO], 1u); break; } }
    }
    nloc = mine > 0u ? mine : 1u; nx = cnt > 0u ? cnt : 1u;
}

__device__ __forceinline__ void xcd_barrier(const XcdBarrier& b) {
    asm volatile("s_waitcnt vmcnt(0)" ::: "memory");
    __syncthreads();
    if (threadIdx.x == 0) {
        __attribute__((address_space(1))) unsigned* bar_g = (__attribute__((address_space(1))) unsigned*)b.bar; asm volatile("" : "+s"(bar_g)); unsigned* bar = (unsigned*)bar_g;
        __builtin_amdgcn_s_waitcnt(0);
        unsigned nloc = b.st[0], nx = b.st[1];
        if (nloc == 0u) { xcd_barrier_complete(bar, b.x, nloc, nx); b.st[0] = nloc; b.st[1] = nx; }
        const unsigned old = xb_add(&bar[XB_XSUB(b.x)], 1u);
        const unsigned gen = old / nloc;
        if (old + 1u == (gen + 1u) * nloc) {
            __builtin_amdgcn_fence(__ATOMIC_RELEASE, "agent");
            asm volatile("s_waitcnt vmcnt(0)" ::: "memory");
            const unsigned og = xb_add(&bar[XB_TOP], 1u);
            const unsigned tg = og / nx;
            if (og + 1u == (tg + 1u) * nx) xb_add(&bar[XB_TOPGEN], 1u);
            else XB_SPIN(xb_ld(&bar[XB_TOPGEN]) == tg, bar);
            __builtin_amdgcn_fence(__ATOMIC_ACQUIRE, "agent");
            asm volatile("s_waitcnt vmcnt(0)" ::: "memory");
        } else {
            XB_SPIN(xb_ld(&bar[XB_TOPGEN]) == gen, bar);
            __builtin_amdgcn_fence(__ATOMIC_ACQUIRE, "agent");
            asm volatile("s_waitcnt vmcnt(0)" ::: "memory");
        }
    }
    __syncthreads();
}

struct Args { const float* in[18]; float* out; unsigned char* ws; int gp_lo, gp_hi, bar_region, pad1; };
constexpr int CW_BAR = 4096, N_BAR_REGIONS = 16;
enum { I_X = 0, I_C, I_CTX, I_CCTX, I_WADA, I_BADA, I_NMIX, I_WIN, I_CONVW, I_ALOG, I_DTB, I_GNORM, I_SINK, I_WOUT, I_NFFN, I_W1, I_W2, I_NFINAL };
struct Frame { LAS unsigned char* lds; int tid, lane, wave, vcu, G, bx; };
__device__ __forceinline__ Args relaunder_args(const Args& a) { Args r = a;
#pragma unroll
    for (int i = 0; i < 18; ++i) { const GAS float* p = (const GAS float*)r.in[i]; asm volatile("" : "+s"(p)); r.in[i] = (const float*)p; }
    { GAS float* p = (GAS float*)r.out; asm volatile("" : "+s"(p)); r.out = (float*)p; } { GAS unsigned char* p = (GAS unsigned char*)r.ws; asm volatile("" : "+s"(p)); r.ws = (unsigned char*)p; }
    return r; }
__device__ __forceinline__ Frame relaunder(const Frame& F0) { Frame F = F0; int ln; asm volatile("v_mbcnt_lo_u32_b32 %0, -1, 0\n\tv_mbcnt_hi_u32_b32 %0, -1, %0" : "=v"(ln));
    int w = F0.wave, v = F0.vcu, G = F0.G, bx = F0.bx; asm volatile("" : "+s"(w), "+s"(v), "+s"(G), "+s"(bx));
    F.lane = ln; F.wave = w; F.vcu = v; F.G = G; F.bx = bx; F.tid = w * 64 + ln; return F; }
constexpr int NPH = 9;
__host__ __device__ constexpr int GP(int layer, int p) { return 1 + layer * NPH + p; }
constexpr int GP_FINAL = 1 + DEPTH * NPH;
constexpr int REP_NB = 0, REP_BAR = 1, REP_XC = 1, REP_CT = 0, REP_G1 = 1, REP_G2 = 1, REP_G3 = 1, REP_G4 = 1, REP_PT = 1, REP_PA = 1, REP_PRO = 1, REP_GEMM = 1, REP_MIX = 1, REP_NORM = 1, REP_PREP = 1, REP_SCAN = 1, REP_ATTN = 1, REP_OUT = 1, REP_FIN = 1;

__device__ __forceinline__ void p0_item_load(const float* W, int N, int item, int lane, f32x4 (&wv)[8]) {
    const int nblk = N / 32, kb = item / nblk, nb = item % nblk, k0 = 64 * kb, n0 = 32 * nb;
#pragma unroll
    for (int i = 0; i < 8; ++i) wv[i] = *(const f32x4*)(W + (size_t)(k0 + 8 * i + (lane >> 3)) * N + n0 + 4 * (lane & 7));
}
__device__ __forceinline__ void p0_item_store(const f32x4 (&wv)[8], int K, int N, bf16* WT, LAS float* scr, int item, int lane, int qkperm) {
    const int nblk = N / 32, kb = item / nblk, nb = item % nblk, k0 = 64 * kb, n0 = 32 * nb;
#pragma unroll
    for (int i = 0; i < 8; ++i) { LAS float* d = scr + (8 * i + (lane >> 3)) * 33 + 4 * (lane & 7); d[0] = wv[i].x; d[1] = wv[i].y; d[2] = wv[i].z; d[3] = wv[i].w; }
    LDS_WAIT(); asm volatile("" ::: "memory");
    const int c = lane & 7;
#pragma unroll
    for (int j = 0; j < 4; ++j) { const int n = (lane >> 3) + 8 * j; const LAS float* s = scr + (8 * c) * 33 + n;
        v4u o; o.x = pk2(s[0 * 33], s[1 * 33]); o.y = pk2(s[2 * 33], s[3 * 33]); o.z = pk2(s[4 * 33], s[5 * 33]); o.w = pk2(s[6 * 33], s[7 * 33]);
        int nd = n0 + n; if (nd < qkperm) { const int w = nd & 63; nd = (nd & ~63) + 2 * (w & 31) + (w >> 5); }
        *(v4u*)(WT + (size_t)nd * K + k0 + 8 * c) = o; }
    LDS_WAIT(); asm volatile("" ::: "memory");
}
constexpr int CV_A = (DM / 64) * (D_IN / 32), CV_B = CV_A + (DM / 64) * (DM / 32), CV_C = CV_B + (DM / 64) * (DFF / 32), CV_LAYER = CV_C + (DFF / 64) * (DM / 32);
#ifndef CV_DEFER
#define CV_DEFER 12288
#endif
#ifndef CV_PREP
#define CV_PREP 4096
#endif
#ifndef CV_P3
#define CV_P3 3648
#endif
constexpr int CV_DEF_ALL = CV_DEFER + CV_PREP + CV_P3;
__device__ __forceinline__ void cv_load(const Args& a, int l, int it, int lane, f32x4 (&wv)[8]) {
    if (it < CV_A) p0_item_load(a.in[I_WIN] + (size_t)l * DM * D_IN, D_IN, it, lane, wv);
    else if (it < CV_B) p0_item_load(a.in[I_WOUT] + (size_t)l * DM * DM, DM, it - CV_A, lane, wv);
    else if (it < CV_C) p0_item_load(a.in[I_W1] + (size_t)l * DM * DFF, DFF, it - CV_B, lane, wv);
    else p0_item_load(a.in[I_W2] + (size_t)l * DFF * DM, DM, it - CV_C, lane, wv);
}
__device__ __forceinline__ void cv_store(const Args& a, const f32x4 (&wv)[8], LAS float* scr, int l, int it, int lane) {
    unsigned char* ws = a.ws;
    if (it < CV_A) p0_item_store(wv, DM, D_IN, (bf16*)(ws + WS_WIN) + (size_t)l * D_INP * DM, scr, it, lane, 1280);
    else if (it < CV_B) p0_item_store(wv, DM, DM, (bf16*)(ws + WS_WOUT) + (size_t)l * DM * DM, scr, it - CV_A, lane, 0);
    else if (it < CV_C) p0_item_store(wv, DM, DFF, (bf16*)(ws + WS_W1) + (size_t)l * DFF * DM, scr, it - CV_B, lane, 0);
    else p0_item_store(wv, DFF, DM, (bf16*)(ws + WS_W2) + (size_t)l * DM * DFF, scr, it - CV_C, lane, 0);
}
constexpr int CV_S0 = CV_C - (CV_PREP + CV_P3), CV_NR = CV_S0 + (CV_LAYER - CV_C), CV_RPRO = CV_NR - CV_DEFER;
static_assert(CV_S0 >= CV_B && CV_RPRO >= 0, "conversion split");
__device__ __forceinline__ int cv_ritem(int q) { return q < CV_S0 ? q : q - CV_S0 + CV_C; }
template <int MODE>
__device__ __forceinline__ void cv_jobs(const Frame& F, const Args& a, int lfix, int base, int njobs, int w, int nw) {
    LAS float* scr = (LAS float*)(F.lds + RING_OFF + F.wave * 16384);
    f32x4 sa[8], sb[8];
#define CV_MAP(g_, l_, it_) do { (l_) = lfix; \
        if (MODE == 2) (it_) = CV_S0 + base + (g_); \
        else if (MODE == 1) (it_) = cv_ritem(g_); \
        else if ((g_) < CV_NR) (it_) = cv_ritem(g_); \
        else { const int q_ = ((g_) - CV_NR) / CV_RPRO; (l_) = 1 + q_; (it_) = cv_ritem(CV_DEFER + ((g_) - CV_NR) - q_ * CV_RPRO); } } while (0)
    for (int g = w; g < njobs; g += 2 * nw) {
        const int g1 = g + nw; int l, it, l1, it1; CV_MAP(g, l, it); CV_MAP(g1, l1, it1);
        cv_load(a, l, it, F.lane, sa);
        if (g1 < njobs) cv_load(a, l1, it1, F.lane, sb);
        cv_store(a, sa, scr, l, it, F.lane);
        if (g1 < njobs) cv_store(a, sb, scr, l1, it1, F.lane);
    }
#undef CV_MAP
}
template <int MODE>
__device__ __forceinline__ void cv_deferred(const Frame& F0, const Args& a0, int lfix, int base, int njobs, int w, int nw) {
    const Frame F = relaunder(F0); const Args a = relaunder_args(a0);
    cv_jobs<MODE>(F, a, lfix, base, njobs, w, nw);
}

__device__ __forceinline__ void p0_prologue(const Frame& F0, const Args& a0) {
    const Frame F = relaunder(F0); const Args a = relaunder_args(a0);
    unsigned char* ws = a.ws;
    for (int rep = 0; rep < REP_PT; ++rep) cv_jobs<0>(F, a, 0, 0, CV_NR + (DEPTH - 1) * CV_RPRO, F.vcu * NWAVES + F.wave, F.G * NWAVES);
    const size_t gt = (size_t)F.vcu * NTHREADS + F.tid, GT = (size_t)F.G * NTHREADS;
    { constexpr size_t per = (size_t)(D_INP - D_IN) * DM * 2 / 16;
      for (size_t i = gt; i < per * DEPTH; i += GT) { const size_t l = i / per, r = i % per;
          ((v4u*)((bf16*)(ws + WS_WIN) + ((size_t)l * D_INP + D_IN) * DM))[r] = (v4u){0u, 0u, 0u, 0u}; } }
    { float* rc = (float*)(ws + WS_ROPE); float* rs = rc + 96 * 32;
      for (size_t i = gt; i < 96 * 32; i += GT) { const int p = (int)i / 32, fi = (int)i % 32; const float pos = (float)(p < 32 ? p : p - 32);
          const float invf = powf(10000.0f, -(float)(2 * fi) / 64.0f), ang = pos * invf; rc[i] = cosf(ang); rs[i] = sinf(ang); } }
    {
        LAS float* sc = (LAS float*)(F.lds + RING_OFF); LAS float* red = (LAS float*)(F.lds + RING_OFF + 49152);
        __syncthreads();
        for (int i = F.tid; i < 5 * DM; i += NTHREADS) { const int r = i / DM, k = i % DM; const float v = (r < 4) ? a.in[I_C][r * DM + k] : a.in[I_CCTX][k]; sc[i] = v / (1.f + expf(-v)); }
        __syncthreads();
        float* MOD = (float*)(ws + WS_MOD);
        for (int rpa = 0; rpa < REP_PA; ++rpa)
        for (int unit = F.vcu; unit < DEPTH * (D6 / 64); unit += F.G) {
            const int l = unit / (D6 / 64), n0 = (unit % (D6 / 64)) * 64, kp = F.lane >> 4, nq = F.lane & 15;
            const float* w = a.in[I_WADA] + ((size_t)l * DM + F.wave * 256 + kp) * D6 + n0 + 4 * nq;
            const LAS float* s = sc + F.wave * 256 + kp;
            f32x4 a0 = (f32x4){0.f, 0.f, 0.f, 0.f}, a1 = a0, a2 = a0, a3 = a0, a4 = a0;
#pragma unroll 8
            for (int k = 0; k < 64; ++k) { const f32x4 wv = *(const f32x4*)(w + (size_t)(4 * k) * D6); a0 += wv * s[4 * k]; a1 += wv * s[DM + 4 * k]; a2 += wv * s[2 * DM + 4 * k]; a3 += wv * s[3 * DM + 4 * k]; a4 += wv * s[4 * DM + 4 * k]; }
#pragma unroll
            for (int e = 0; e < 4; ++e) { a0[e] += shx(a0[e], 32, F.lane); a1[e] += shx(a1[e], 32, F.lane); a2[e] += shx(a2[e], 32, F.lane); a3[e] += shx(a3[e], 32, F.lane); a4[e] += shx(a4[e], 32, F.lane);
                a0[e] += shx(a0[e], 16, F.lane); a1[e] += shx(a1[e], 16, F.lane); a2[e] += shx(a2[e], 16, F.lane); a3[e] += shx(a3[e], 16, F.lane); a4[e] += shx(a4[e], 16, F.lane); }
            if (kp == 0) { LAS f32x4* r4 = (LAS f32x4*)red + (F.wave * 5) * 16 + nq; r4[0] = a0; r4[16] = a1; r4[32] = a2; r4[48] = a3; r4[64] = a4; }
            __syncthreads();
            for (int o = F.tid; o < 5 * 64; o += NTHREADS) { const int r = o / 64, cl = o % 64; float sum = 0.f;
#pragma unroll
                for (int wv = 0; wv < 8; ++wv) sum += red[(wv * 5 + r) * 64 + cl];
                MOD[((size_t)l * 5 + r) * D6 + n0 + cl] = sum + a.in[I_BADA][(size_t)l * D6 + n0 + cl]; }
            __syncthreads();
        }
    }
}

__device__ __forceinline__ void norm_mod_phase(const Frame& F0, const Args& a0, int l, int which, bool skip_ctx, const float* slabgate) {
    const Frame F = relaunder(F0); const Args a = relaunder_args(a0);
    const float* X = (const float*)(a.ws + WS_X); bf16* H = (bf16*)(a.ws + WS_H);
    const float* gain = a.in[which ? I_NFFN : I_NMIX] + (size_t)l * DM;
    const float* modl = (const float*)(a.ws + WS_MOD) + (size_t)l * 5 * D6;
    const int gw = F.vcu * NWAVES + F.wave, NGW = F.G * NWAVES;
    LAS f32x4* ca = (LAS f32x4*)(F.lds + RING_OFF); LAS f32x4* cb = ca + 5 * (DM / 4); LAS f32x4* cg = cb + 5 * (DM / 4);
    { f32x4 g[5], sc[5], sh[5];
#pragma unroll
      for (int r = 0; r < 5; ++r) { const float* shift = modl + (size_t)r * D6 + (which ? 3 * DM : 0);
          g[r] = ((const f32x4*)gain)[F.tid]; sc[r] = ((const f32x4*)(shift + DM))[F.tid]; sh[r] = ((const f32x4*)shift)[F.tid]; }
      f32x4 gt4 = (f32x4){0.f, 0.f, 0.f, 0.f}; if (slabgate != nullptr) gt4 = ((const f32x4*)slabgate)[F.tid];
      __builtin_amdgcn_sched_barrier(0);
#pragma unroll
      for (int r = 0; r < 5; ++r) { ca[r * (DM / 4) + F.tid] = g[r] * (sc[r] + 1.0f); cb[r * (DM / 4) + F.tid] = sh[r]; }
      cg[F.tid] = gt4; }
    __syncthreads();
    int m = gw, mstep = NGW, mlim = M;
    if (slabgate != nullptr) { const int idx = (F.wave >> 1) + 4 * F.vcu; if (F.wave & 1) { m = idx; mstep = NGW / 2; mlim = 8192; } else { m = 8192 + idx; mstep = M; } }
#define NM_NEXT(mm) do { while ((mm) < mlim && skip_ctx && ((mm) % TT) < CTXL) (mm) += mstep; } while (0)
    NM_NEXT(m);
    f32x4 v[8], vn[8];
    const bool fromin = (l == 0 && which == 0);
#define NM_ROW(mm) ((const f32x4*)(fromin ? ((mm) % TT < CTXL ? a.in[I_CTX] + ((size_t)((mm) / TT) * CTXL + (mm) % TT) * DM : a.in[I_X] + ((size_t)((mm) / TT) * SEQ + ((mm) % TT - CTXL)) * DM) : X + (size_t)(mm) * DM) + F.lane)
    if (m < mlim) { const f32x4* xr = NM_ROW(m);
#pragma unroll
        for (int j = 0; j < 8; ++j) v[j] = xr[64 * j]; }
    while (m < mlim) {
        int mn = m + mstep; NM_NEXT(mn);
        if (mn < mlim) { const f32x4* xr = NM_ROW(mn);
#pragma unroll
            for (int j = 0; j < 8; ++j) vn[j] = xr[64 * j]; }
        const int b = m / TT, t = m - b * TT; const int r = (t < CTXL) ? 4 : b;
        float ss = 0.f;
        if (slabgate != nullptr && m >= 8192) {
            const f32x4* sl = (const f32x4*)((const float*)(a.ws + WS_SLAB) + (size_t)(m - 8192) * DM) + F.lane;
#pragma unroll
            for (int jp = 0; jp < 4; ++jp) {
                f32x4 sv[2][8];
#pragma unroll
                for (int jj = 0; jj < 2; ++jj)
#pragma unroll
                    for (int ks = 0; ks < 8; ++ks) sv[jj][ks] = sl[(size_t)ks * 1024 * (DM / 4) + 64 * (2 * jp + jj)];
                __builtin_amdgcn_sched_barrier(0);
#pragma unroll
                for (int jj = 0; jj < 2; ++jj) { const int j = 2 * jp + jj;
                    const f32x4 sum = ((sv[jj][0] + sv[jj][1]) + (sv[jj][2] + sv[jj][3])) + ((sv[jj][4] + sv[jj][5]) + (sv[jj][6] + sv[jj][7]));
                    v[j] = v[j] + cg[F.lane + 64 * j] * sum;
                    ((f32x4*)(a.ws + WS_X) + (size_t)m * (DM / 4) + F.lane)[64 * j] = v[j]; }
                __builtin_amdgcn_sched_barrier(0);
            }
        }
#pragma unroll
        for (int j = 0; j < 8; ++j) ss += (v[j].x * v[j].x + v[j].y * v[j].y) + (v[j].z * v[j].z + v[j].w * v[j].w);
        const float rstd = 1.0f / sqrtf(wave_sum(ss, F.lane) * (1.f / DM) + EPS);
        if (fromin) { f32x4* xo = (f32x4*)(a.ws + WS_X) + (size_t)m * (DM / 4) + F.lane;
#pragma unroll
            for (int j = 0; j < 8; ++j) xo[64 * j] = v[j]; }
        v2u* o8 = (v2u*)(H + (size_t)m * DM) + F.lane;
#pragma unroll
        for (int j = 0; j < 8; ++j) {
            const f32x4 h = v[j] * rstd * ca[r * (DM / 4) + F.lane + 64 * j] + cb[r * (DM / 4) + F.lane + 64 * j];
            v2u w; w.x = pk2(h.x, h.y); w.y = pk2(h.z, h.w); o8[64 * j] = w; }
#pragma unroll
        for (int j = 0; j < 8; ++j) v[j] = vn[j];
        m = mn;
    }
#undef NM_NEXT
#undef NM_ROW
}
__device__ __forceinline__ void final_norm_phase(const Frame& F0, const Args& a0) {
    const Frame F = relaunder(F0); const Args a = relaunder_args(a0);
    const float* X = (const float*)(a.ws + WS_X); const float* gain = a.in[I_NFINAL];
    const int gw = F.vcu * NWAVES + F.wave, NGW = F.G * NWAVES;
    f32x4 gn[8];
#pragma unroll
    for (int j = 0; j < 8; ++j) gn[j] = *(const f32x4*)(gain + (F.lane + 64 * j) * 4);
    f32x4 v[8], vn[8];
    int r = gw;
    if (r < NB * SEQ) { const int b = r / SEQ, t = r - b * SEQ; const f32x4* xr = (const f32x4*)(X + ((size_t)b * TT + CTXL + t) * DM) + F.lane;
#pragma unroll
        for (int j = 0; j < 8; ++j) v[j] = xr[64 * j]; }
    while (r < NB * SEQ) {
        const int rn = r + NGW;
        if (rn < NB * SEQ) { const int b = rn / SEQ, t = rn - b * SEQ; const f32x4* xr = (const f32x4*)(X + ((size_t)b * TT + CTXL + t) * DM) + F.lane;
#pragma unroll
            for (int j = 0; j < 8; ++j) vn[j] = xr[64 * j]; }
        __builtin_amdgcn_sched_barrier(0);
        float ss = 0.f;
#pragma unroll
        for (int j = 0; j < 8; ++j) ss += (v[j].x * v[j].x + v[j].y * v[j].y) + (v[j].z * v[j].z + v[j].w * v[j].w);
        const float rstd = 1.0f / sqrtf(wave_sum(ss, F.lane) * (1.f / DM) + EPS);
        f32x4* o = (f32x4*)(a.out + (size_t)r * DM) + F.lane;
#pragma unroll
        for (int j = 0; j < 8; ++j) o[64 * j] = v[j] * rstd * gn[j];
#pragma unroll
        for (int j = 0; j < 8; ++j) v[j] = vn[j];
        r = rn;
    }
}

typedef short bf16x8 __attribute__((ext_vector_type(8)));
typedef short s16x4 __attribute__((ext_vector_type(4)));
constexpr int AT_KP = 272, AT_VP = 288, AT_KB = 64 * AT_KP, AT_VB = 64 * AT_VP, AT_STG = AT_KB + AT_VB;
static_assert(2 * AT_STG <= RING_BYTES, "attention LDS");
typedef __bf16 bf16x2n __attribute__((ext_vector_type(2)));
typedef float f32x2n __attribute__((ext_vector_type(2)));
__device__ __forceinline__ unsigned cvtpk(float lo, float hi) { return __builtin_bit_cast(unsigned, __builtin_convertvector((f32x2n){lo, hi}, bf16x2n)); }
__device__ __forceinline__ bf16x8 pack8(const f32x4& a, const f32x4& b) {
    v4u w; w.x = cvtpk(a[0], a[1]); w.y = cvtpk(a[2], a[3]); w.z = cvtpk(b[0], b[1]); w.w = cvtpk(b[2], b[3]);
    return __builtin_bit_cast(bf16x8, w);
}
template <int OFF>
__device__ __forceinline__ void tr8(unsigned va, s16x4 (&r)[8]) {
    asm volatile("ds_read_b64_tr_b16 %0, %8 offset:%9\n\t"
                 "ds_read_b64_tr_b16 %1, %8 offset:%10\n\t"
                 "ds_read_b64_tr_b16 %2, %8 offset:%11\n\t"
                 "ds_read_b64_tr_b16 %3, %8 offset:%12\n\t"
                 "ds_read_b64_tr_b16 %4, %8 offset:%13\n\t"
                 "ds_read_b64_tr_b16 %5, %8 offset:%14\n\t"
                 "ds_read_b64_tr_b16 %6, %8 offset:%15\n\t"
                 "ds_read_b64_tr_b16 %7, %8 offset:%16\n\t"
                 "s_waitcnt lgkmcnt(0)"
                 : "=&v"(r[0]), "=&v"(r[1]), "=&v"(r[2]), "=&v"(r[3]), "=&v"(r[4]), "=&v"(r[5]), "=&v"(r[6]), "=&v"(r[7])
                 : "v"(va), "i"(OFF), "i"(OFF + 16 * AT_VP), "i"(OFF + 32 * AT_VP), "i"(OFF + 48 * AT_VP),
                   "i"(OFF + 32), "i"(OFF + 32 + 16 * AT_VP), "i"(OFF + 32 + 32 * AT_VP), "i"(OFF + 32 + 48 * AT_VP)
                 : "memory");
}
template <int DTP>
__device__ __forceinline__ void pv_pair(f32x4 (&ot)[8], unsigned va, const bf16x8 (&Pf)[2]) {
    s16x4 r[8]; tr8<DTP * 64>(va, r);
    const bf16x8 a00 = __builtin_shufflevector(r[0], r[1], 0, 1, 2, 3, 4, 5, 6, 7), a01 = __builtin_shufflevector(r[2], r[3], 0, 1, 2, 3, 4, 5, 6, 7);
    const bf16x8 a10 = __builtin_shufflevector(r[4], r[5], 0, 1, 2, 3, 4, 5, 6, 7), a11 = __builtin_shufflevector(r[6], r[7], 0, 1, 2, 3, 4, 5, 6, 7);
    ot[2 * DTP] = __builtin_amdgcn_mfma_f32_16x16x32_bf16(a00, Pf[0], ot[2 * DTP], 0, 0, 0);
    ot[2 * DTP] = __builtin_amdgcn_mfma_f32_16x16x32_bf16(a01, Pf[1], ot[2 * DTP], 0, 0, 0);
    ot[2 * DTP + 1] = __builtin_amdgcn_mfma_f32_16x16x32_bf16(a10, Pf[0], ot[2 * DTP + 1], 0, 0, 0);
    ot[2 * DTP + 1] = __builtin_amdgcn_mfma_f32_16x16x32_bf16(a11, Pf[1], ot[2 * DTP + 1], 0, 0, 0);
}
__device__ __forceinline__ void attn_phase(const Frame& F0, const Args& a0, int l, int u0, int ustride, int ucount, int ulimit, int uextra, bool last) {
    const Frame F = relaunder(F0); const Args a = relaunder_args(a0);
    const bf16* Z = (const bf16*)(a.ws + WS_Z); bf16* MIX = (bf16*)(a.ws + WS_MIX);
    const float* sink = a.in[I_SINK] + l * 8;
    const int wave = F.wave, lane = F.lane, c = lane & 15, g = lane >> 4, tid = F.tid;
    LAS unsigned char* lds = F.lds + RING_OFF;
    const unsigned ldsbase = (unsigned)(size_t)lds;
    const unsigned va_lane = (unsigned)((4 * g + (c >> 2)) * AT_VP + 8 * (c & 3));
    const int srow0 = tid >> 4, sch = tid & 15;
    constexpr float SC = 0.08838834764831845f * 1.4426950408889634f;
    const int nall = last ? 512 : 576, nunits = nall < ulimit ? nall : ulimit;
    for (int ui = 0; ui <= ucount; ++ui) {
        const int u = (ui < ucount) ? u0 + ui * ustride : uextra;
        if (ui < ucount ? (u >= nunits) : (u < 0 || u >= nall)) continue;
        int hq, qb, kvh, b; bool isctx;
        if (u < 512) { hq = u & 3; qb = (u >> 2) & 15; kvh = (u >> 6) & 1; b = u >> 7; isctx = false; }
        else { const int uc = u - 512; hq = uc & 3; qb = (uc >> 2) & 1; kvh = (uc >> 3) & 1; b = uc >> 4; isctx = true; }
        const int head = kvh * 4 + hq;
        const int qrow0 = b * TT + (isctx ? qb * 128 : CTXL + qb * 128);
        const int firstb = isctx ? 0 : (qb > 0 ? qb - 1 : 0), lastb = isctx ? -1 : (qb < 15 ? qb + 1 : 15);
        const int nloc = isctx ? 0 : (lastb - firstb + 1) * 2, NT = nloc + 4;
        bf16x8 Qf[4];
        { const bf16* qp = Z + (size_t)(qrow0 + 16 * wave + c) * ZP + head * 128 + 8 * g;
#pragma unroll
          for (int kb = 0; kb < 4; ++kb) Qf[kb] = *(const bf16x8*)(qp + 32 * kb); }
        float m = sink[head] * 1.4426950408889634f, lsum = (g == 0) ? 1.f : 0.f;
        f32x4 ot[8];
#pragma unroll
        for (int dt = 0; dt < 8; ++dt) ot[dt] = (f32x4){0.f, 0.f, 0.f, 0.f};
        const size_t kvcol = (size_t)OFF_AK + kvh * 128 + sch * 8;
        v4u sk0, sk1, sv0, sv1;
#define AT_TILE_ROW(ti) ((ti) < nloc ? b * TT + CTXL + (firstb + ((ti) >> 1)) * 128 + ((ti) & 1) * 64 : b * TT + ((ti) - nloc) * 64)
#define AT_LOAD(ti) do { const bf16* src = Z + (size_t)(AT_TILE_ROW(ti) + srow0) * ZP + kvcol; \
            sk0 = *(const v4u*)(src); sk1 = *(const v4u*)(src + (size_t)32 * ZP); sv0 = *(const v4u*)(src + 256); sv1 = *(const v4u*)(src + (size_t)32 * ZP + 256); } while (0)
#define AT_STORE(buf) do { LAS unsigned char* kb_ = lds + (buf) * AT_STG; \
            *(LAS v4u*)(kb_ + srow0 * AT_KP + sch * 16) = sk0; *(LAS v4u*)(kb_ + (srow0 + 32) * AT_KP + sch * 16) = sk1; \
            *(LAS v4u*)(kb_ + AT_KB + srow0 * AT_VP + sch * 16) = sv0; *(LAS v4u*)(kb_ + AT_KB + (srow0 + 32) * AT_VP + sch * 16) = sv1; } while (0)
        AT_LOAD(0); AT_STORE(0); __syncthreads();
        for (int ti = 0; ti < NT; ++ti) {
            if (ti + 1 < NT) AT_LOAD(ti + 1);
            const LAS unsigned char* Kb = lds + (ti & 1) * AT_STG;
            const unsigned va = ldsbase + (unsigned)((ti & 1) * AT_STG + AT_KB) + va_lane;
            int type = 0; const int sub = ti & 1;
            if (ti < nloc) { const int blk = firstb + (ti >> 1); type = blk < qb ? 1 : (blk > qb ? 2 : 0); }
            f32x4 st[4]; bf16x8 kf[16];
#pragma unroll
            for (int i = 0; i < 16; ++i) kf[i] = *(const LAS bf16x8*)(Kb + (16 * (i >> 2) + c) * AT_KP + (32 * (i & 3) + 8 * g) * 2);
            __builtin_amdgcn_sched_barrier(0);
#pragma unroll
            for (int kt = 0; kt < 4; ++kt) st[kt] = (f32x4){0.f, 0.f, 0.f, 0.f};
#pragma unroll
            for (int kb = 0; kb < 4; ++kb)
#pragma unroll
                for (int kt = 0; kt < 4; ++kt) st[kt] = __builtin_amdgcn_mfma_f32_16x16x32_bf16(kf[4 * kt + kb], Qf[kb], st[kt], 0, 0, 0);
            s16x4 vr[32];
#pragma unroll
            for (int dtp = 0; dtp < 4; ++dtp)
#pragma unroll
                for (int e = 0; e < 8; ++e) vr[8 * dtp + e] = __builtin_amdgcn_ds_read_tr16_b64_v4i16((LAS s16x4*)(va + (unsigned)(dtp * 64 + (e >> 2) * 32 + (e & 3) * 16 * AT_VP)));
            __builtin_amdgcn_sched_barrier(0);
            float mx = -1e30f; const int ii = 16 * wave + c;
            if (type != 0) {
                const int jb = 64 * sub + 4 * g, lo = (type == 1 ? ii : -4096) - jb, span = (type == 2 ? ii : 4096) - jb - lo;
#pragma unroll
                for (int kt = 0; kt < 4; ++kt)
#pragma unroll
                    for (int r = 0; r < 4; ++r) st[kt][r] = ((unsigned)(16 * kt + r - lo) <= (unsigned)span) ? st[kt][r] : -1e30f;
            }
#pragma unroll
            for (int kt = 0; kt < 4; ++kt)
#pragma unroll
                for (int r = 0; r < 4; ++r) { const float t = st[kt][r] * SC; st[kt][r] = t; mx = fmaxf(mx, t); }
            mx = fmaxf(mx, shx(mx, 16, lane)); mx = fmaxf(mx, shx(mx, 32, lane));
            const float mn = fmaxf(m, mx), alpha = __builtin_amdgcn_exp2f(m - mn); m = mn;
            lsum *= alpha;
#pragma unroll
            for (int dt = 0; dt < 8; ++dt) ot[dt] = ot[dt] * alpha;
            float ps = 0.f;
#pragma unroll
            for (int kt = 0; kt < 4; ++kt)
#pragma unroll
                for (int r = 0; r < 4; ++r) { const float p = __builtin_amdgcn_exp2f(st[kt][r] - mn); st[kt][r] = p; ps += p; }
            lsum += ps;
            bf16x8 Pf[2]; Pf[0] = pack8(st[0], st[1]); Pf[1] = pack8(st[2], st[3]);
#pragma unroll
            for (int dtp = 0; dtp < 4; ++dtp) {
                const bf16x8 a00 = __builtin_shufflevector(vr[8 * dtp + 0], vr[8 * dtp + 1], 0, 1, 2, 3, 4, 5, 6, 7), a01 = __builtin_shufflevector(vr[8 * dtp + 2], vr[8 * dtp + 3], 0, 1, 2, 3, 4, 5, 6, 7);
                const bf16x8 a10 = __builtin_shufflevector(vr[8 * dtp + 4], vr[8 * dtp + 5], 0, 1, 2, 3, 4, 5, 6, 7), a11 = __builtin_shufflevector(vr[8 * dtp + 6], vr[8 * dtp + 7], 0, 1, 2, 3, 4, 5, 6, 7);
                ot[2 * dtp] = __builtin_amdgcn_mfma_f32_16x16x32_bf16(a00, Pf[0], ot[2 * dtp], 0, 0, 0);
                ot[2 * dtp] = __builtin_amdgcn_mfma_f32_16x16x32_bf16(a01, Pf[1], ot[2 * dtp], 0, 0, 0);
                ot[2 * dtp + 1] = __builtin_amdgcn_mfma_f32_16x16x32_bf16(a10, Pf[0], ot[2 * dtp + 1], 0, 0, 0);
                ot[2 * dtp + 1] = __builtin_amdgcn_mfma_f32_16x16x32_bf16(a11, Pf[1], ot[2 * dtp + 1], 0, 0, 0); }
            if (ti + 1 < NT) AT_STORE((ti + 1) & 1);
            __syncthreads();
        }
#undef AT_TILE_ROW
#undef AT_LOAD
#undef AT_STORE
        lsum += shx(lsum, 16, lane); lsum += shx(lsum, 32, lane);
        const float inv = 1.0f / lsum;
        bf16* op = MIX + (size_t)(qrow0 + 16 * wave + c) * 2048 + head * 128 + 4 * g;
#pragma unroll
        for (int dt = 0; dt < 8; ++dt) { v2u w; w.x = cvtpk(ot[dt][0] * inv, ot[dt][1] * inv); w.y = cvtpk(ot[dt][2] * inv, ot[dt][3] * inv); *(v2u*)(op + 16 * dt) = w; }
    }
}

constexpr int GD_PITCH = 272;
constexpr int GD_QS = 0, GD_KS = 17408, GD_VS = 34816, GD_AD = 52224  , GD_MD = 89088  ,
              GD_QKB = 123904, GD_QKP = 144, GD_GATES = 142336, GD_MPP = 144;
constexpr int GD_REC = 57344;
constexpr int REP_SLEEP = 0, REP_GA = 1, REP_GC = 1, REP_GD = 1, REP_GD5 = 1, REP_GD6 = 1, REP_GE = 1;
static_assert(GD_AD + 36864 <= GD_MD && GD_MD + 34816 <= GD_QKB && GD_QKB + 18432 <= GD_GATES && GD_GATES + 2560 <= RING_BYTES, "gdn LDS");
__device__ __forceinline__ float softplusf(float x) { return x > 20.f ? x : __logf(1.0f + __expf(x)); }

__device__ __forceinline__ bf16x8 gd_tr_pair(unsigned a0, unsigned a1) {
    s16x4 lo, hi;
    asm volatile("ds_read_b64_tr_b16 %0, %2\n\tds_read_b64_tr_b16 %1, %3\n\ts_waitcnt lgkmcnt(0)" : "=&v"(lo), "=&v"(hi) : "v"(a0), "v"(a1) : "memory");
    return __builtin_shufflevector(lo, hi, 0, 1, 2, 3, 4, 5, 6, 7);
}
__device__ __forceinline__ void gdn_prep_phase(const Frame& F0, const Args& a0, int l) {
    const Frame F = relaunder(F0); const Args a = relaunder_args(a0);
    const bf16* Z = (const bf16*)(a.ws + WS_Z); const float* AB = (const float*)(a.ws + WS_AB);
    const float* convw = a.in[I_CONVW] + (size_t)l * 5 * 3072; const float* alog = a.in[I_ALOG] + l * 16; const float* dtb = a.in[I_DTB] + l * 16;
    unsigned char* RECB = a.ws + WS_GREC; float* UB = (float*)(a.ws + WS_GU); float* GLB = (float*)(a.ws + WS_GL);
    LAS unsigned char* lds = F.lds + RING_OFF;
    const int tid = F.tid, lane = F.lane, wave = F.wave;
    LAS float* gcs = (LAS float*)(lds + GD_GATES); LAS float* bts = gcs + 128; LAS float* egs = gcs + 256; LAS float* ekd = gcs + 384;
    v2u zr[20]; f32x4 cw[5]; float pab0 = 0.f, pab1 = 0.f;
#define GD_PREFETCH(un_) do { const int c_ = (un_) % 36, h_ = ((un_) / 36) & 7, b_ = (un_) / 288, m0_ = b_ * TT + 64 * c_; \
        const int tl0_ = (c_ < 4) ? 64 * c_ : 64 * (c_ - 4), L_ = (c_ < 4) ? CTXL : SEQ; \
        int tp_; asm volatile("v_mbcnt_lo_u32_b32 %0, -1, 0\n\tv_mbcnt_hi_u32_b32 %0, -1, %0" : "=v"(tp_)); \
        { const int q4_ = tp_ & 31, part_ = (wave < 4) ? (tp_ >> 5) : 2, r0_ = (wave < 4) ? 16 * wave : 8 * (2 * (wave - 4) + (tp_ >> 5)), ch_ = part_ * 1024 + h_ * 128 + 4 * q4_; \
            _Pragma("unroll") for (int j_ = 0; j_ < 5; ++j_) cw[j_] = *(const f32x4*)(convw + j_ * 3072 + ch_); \
            _Pragma("unroll") for (int rr_ = 0; rr_ < 20; ++rr_) if (rr_ < 12 || wave < 4) { const int tloc_ = tl0_ + r0_ + rr_ - 2, tcl_ = tloc_ < 0 ? 0 : (tloc_ >= L_ ? L_ - 1 : tloc_); \
                zr[rr_] = *(const v2u*)(Z + (size_t)(m0_ - tl0_ + tcl_) * ZP + OFF_GQKV + ch_); } } \
        { const int d_ = wave & 1, tok_ = d_ ? 63 - tp_ : tp_; pab0 = AB[(size_t)(m0_ + tok_) * 32 + d_ * 16 + h_]; pab1 = AB[(size_t)(m0_ + tok_) * 32 + d_ * 16 + 8 + h_]; } } while (0)
    if (F.vcu < NB * 8 * 36) GD_PREFETCH(F.vcu);
    for (int u = F.vcu; u < NB * 8 * 36; u += F.G) {
        const int c = u % 36, h = (u / 36) & 7, b = u / 288;
        LDS_BARRIER();
        int ta_; asm volatile("v_mbcnt_lo_u32_b32 %0, -1, 0\n\tv_mbcnt_hi_u32_b32 %0, -1, %0" : "=v"(ta_));
#define GD_CONV(NR, NORM) do { \
            { const int tl0 = (c < 4) ? 64 * c : 64 * (c - 4), L = (c < 4) ? CTXL : SEQ; \
              if (tl0 + r0 == 0) { zr[0] = (v2u){0u, 0u}; zr[1] = (v2u){0u, 0u}; } \
              if (tl0 + r0 + NR == L) { zr[NR + 2] = (v2u){0u, 0u}; zr[NR + 3] = (v2u){0u, 0u}; } } \
            f32x4 y[NR]; float ss[NR]; \
            _Pragma("unroll") for (int r = 0; r < NR; ++r) { \
                y[r] = (f32x4){0.f, 0.f, 0.f, 0.f}; \
                _Pragma("unroll") for (int j = 0; j < 5; ++j) { const v2u z = zr[r + j]; y[r] += (f32x4){bflo(z.x), bfhi(z.x), bflo(z.y), bfhi(z.y)} * cw[j]; } \
                _Pragma("unroll") for (int e = 0; e < 4; ++e) y[r][e] = y[r][e] * __builtin_amdgcn_rcpf(1.f + __expf(-y[r][e])); \
                ss[r] = (y[r][0] * y[r][0] + y[r][1] * y[r][1]) + (y[r][2] * y[r][2] + y[r][3] * y[r][3]); } \
            if (NORM) {                                             \
                _Pragma("unroll") for (int o = 1; o < 32; o <<= 1) { float t[NR]; \
                    _Pragma("unroll") for (int r = 0; r < NR; ++r) t[r] = shx(ss[r], o, ta_); \
                    _Pragma("unroll") for (int r = 0; r < NR; ++r) ss[r] += t[r]; } \
                _Pragma("unroll") for (int r = 0; r < NR; ++r) y[r] = y[r] * (__builtin_amdgcn_rsqf(ss[r] + EPS) * (part == 0 ? 0.08838834764831845f : 1.0f)); } \
            _Pragma("unroll") for (int r = 0; r < NR; ++r) { v2u o; o.x = cvtpk(y[r][0], y[r][1]); o.y = cvtpk(y[r][2], y[r][3]); \
                *(LAS v2u*)(lds + part * 17408 + (r0 + r) * GD_PITCH + q4 * 8) = o; } } while (0)
        { const int q4 = ta_ & 31;
          if (wave < 4) { const int part = ta_ >> 5, r0 = 16 * wave; GD_CONV(16, true); }
          else { const int part = 2, r0 = 8 * (2 * (wave - 4) + (ta_ >> 5)); GD_CONV(8, false); } }
#undef GD_CONV
        if (wave >= 6) { int lb_; asm volatile("v_mbcnt_lo_u32_b32 %0, -1, 0\n\tv_mbcnt_hi_u32_b32 %0, -1, %0" : "=v"(lb_)); const int lane = lb_;
            const int d = wave - 6;
            float gc = -__expf(alog[d * 8 + h]) * softplusf(pab0 + dtb[d * 8 + h]);
            const float bt = 1.f / (1.f + __expf(-pab1));
#pragma unroll
            for (int o = 1; o < 64; o <<= 1) { const float t = __builtin_bit_cast(float, __builtin_amdgcn_ds_bpermute(((lane - o) & 63) << 2, __builtin_bit_cast(int, gc))); if (lane >= o) gc += t; }
            const float tot = __builtin_bit_cast(float, __builtin_amdgcn_readlane(__builtin_bit_cast(int, gc), 63));
            gcs[d * 64 + lane] = gc; bts[d * 64 + lane] = bt; egs[d * 64 + lane] = __expf(gc); ekd[d * 64 + lane] = __expf(tot - gc);
            if (lane == 63) GLB[(size_t)((b * 8 + h) * 2 + d) * 36 + c] = __expf(tot); }
        if (wave == 5) gcs[512 + (F.lane)] = 1.0f;
        LDS_BARRIER();
        for (int repc = 0; repc < REP_GC; ++repc) {
            int tl_; asm volatile("v_mbcnt_lo_u32_b32 %0, -1, 0\n\tv_mbcnt_hi_u32_b32 %0, -1, %0" : "=v"(tl_)); const int lane = tl_;
            const int d = wave >> 2, rt = wave & 3, i = lane & 15, g = lane >> 4;
            const int prow = 16 * rt + i, trow = d ? 63 - prow : prow;
            bf16x8 aK[4], aQ[4];
#pragma unroll
            for (int kb = 0; kb < 4; ++kb) { aK[kb] = *(const LAS bf16x8*)(lds + GD_KS + trow * GD_PITCH + (32 * kb + 8 * g) * 2); aQ[kb] = *(const LAS bf16x8*)(lds + GD_QS + trow * GD_PITCH + (32 * kb + 8 * g) * 2); }
            LAS unsigned char* AD = lds + GD_AD + d * 17408; LAS unsigned char* QKB = lds + GD_QKB + d * 9216;
            float gpv[4], btv[4];
#pragma unroll
            for (int r = 0; r < 4; ++r) { gpv[r] = gcs[d * 64 + 16 * rt + 4 * g + r]; btv[r] = bts[d * 64 + 16 * rt + 4 * g + r]; }
#pragma unroll
            for (int ct = 0; ct < 4; ++ct) {
                if (ct <= rt) {
                    const int pcol = 16 * ct + i, tcol = d ? 63 - pcol : pcol;
                    f32x4 kk = (f32x4){0.f, 0.f, 0.f, 0.f}, qk = (f32x4){0.f, 0.f, 0.f, 0.f};
#pragma unroll
                    for (int kb = 0; kb < 4; ++kb) { const bf16x8 bK = *(const LAS bf16x8*)(lds + GD_KS + tcol * GD_PITCH + (32 * kb + 8 * g) * 2);
                        kk = __builtin_amdgcn_mfma_f32_16x16x32_bf16(aK[kb], bK, kk, 0, 0, 0); qk = __builtin_amdgcn_mfma_f32_16x16x32_bf16(aQ[kb], bK, qk, 0, 0, 0); }
                    const int pq = 16 * ct + i; const float gq = gcs[d * 64 + pq];
#pragma unroll
                    for (int r = 0; r < 4; ++r) { const int p = 16 * rt + 4 * g + r; const float dec = __expf(fminf(gpv[r] - gq, 0.f));
                        *(LAS float*)(AD + p * GD_PITCH + pq * 4) = (pq < p) ? btv[r] * kk[r] * dec : 0.f;
                        *(LAS bf16*)(QKB + p * GD_QKP + pq * 2) = (bf16)f2bf((pq <= p) ? qk[r] * dec : 0.f); }
                } else {
#pragma unroll
                    for (int r = 0; r < 4; ++r) *(LAS bf16*)(QKB + (16 * rt + 4 * g + r) * GD_QKP + (16 * ct + i) * 2) = (bf16)0;
                }
            }
        }
        LDS_BARRIER();
        if (u + F.G < NB * 8 * 36) GD_PREFETCH(u + F.G);
        {
            int td_; asm volatile("v_mbcnt_lo_u32_b32 %0, -1, 0\n\tv_mbcnt_hi_u32_b32 %0, -1, %0" : "=v"(td_)); const int lane = td_, tid2 = td_ + wave * 64;
            const int cc = lane & 15, g = lane >> 4;
            for (int repd = 0; repd < REP_GD; ++repd) {
            if (tid2 < 128) { const int d = tid2 >> 6, bi = (tid2 >> 4) & 3, col = tid2 & 15;
                const LAS unsigned char* Ab = lds + GD_AD + d * 17408 + (16 * bi) * GD_PITCH + (16 * bi) * 4; LAS unsigned char* Mb = lds + GD_MD + d * 17408 + (16 * bi) * GD_PITCH + (16 * bi) * 4;
                float x[16];
#pragma unroll
                for (int r = 0; r < 16; ++r) { float acc = (r == col) ? 1.f : 0.f;
                    f32x4 av[4];
#pragma unroll
                    for (int q4 = 0; q4 < 4; ++q4) if (4 * q4 < r) av[q4] = *(const LAS f32x4*)(Ab + r * GD_PITCH + q4 * 16);
#pragma unroll
                    for (int j = 0; j < 16; ++j) if (j < r) acc -= av[j >> 2][j & 3] * x[j];
                    x[r] = acc; *(LAS float*)(Mb + r * GD_PITCH + col * 4) = acc; }
            }
            LDS_BARRIER();
#define GD_AEL(d_, r_, c_) (*(const LAS float*)(lds + GD_AD + (d_) * 17408 + (r_) * GD_PITCH + (c_) * 4))
#define GD_MEL(d_, r_, c_) (*(LAS float*)(lds + GD_MD + (d_) * 17408 + (r_) * GD_PITCH + (c_) * 4))
#pragma unroll
            for (int lev = 1; lev <= 3; ++lev) {
                const int nb = 4 - lev;
                if (wave < 2 * nb) { const int d = wave / nb, bj = wave % nb, bi = bj + lev;
                    f32x4 t = (f32x4){0.f, 0.f, 0.f, 0.f};
#pragma unroll
                    for (int k = 0; k < 3; ++k) if (k < lev) { const int bk = bj + k;
#pragma unroll
                        for (int s = 0; s < 4; ++s) t = __builtin_amdgcn_mfma_f32_16x16x4f32(GD_AEL(d, 16 * bi + cc, 16 * bk + 4 * s + g), GD_MEL(d, 16 * bk + 4 * s + g, 16 * bj + cc), t, 0, 0, 0); }
                    f32x4 m2 = (f32x4){0.f, 0.f, 0.f, 0.f};
#pragma unroll
                    for (int s = 0; s < 4; ++s) m2 = __builtin_amdgcn_mfma_f32_16x16x4f32(GD_MEL(d, 16 * bi + cc, 16 * bi + 4 * g + s), t[s], m2, 0, 0, 0);
#pragma unroll
                    for (int r = 0; r < 4; ++r) GD_MEL(d, 16 * bi + 4 * g + r, 16 * bj + cc) = -m2[r];
                }
                LDS_BARRIER();
            }
            }
#undef GD_AEL
            for (int repd5 = 0; repd5 < REP_GD5; ++repd5) {
            { const int d = tid2 >> 8, p = (tid2 >> 2) & 63, q = tid2 & 3;
                float mv[16];
                if (16 * q <= p) {
#pragma unroll
                    for (int q4 = 0; q4 < 4; ++q4) { const f32x4 v4 = *(const LAS f32x4*)(lds + GD_MD + d * 17408 + p * GD_PITCH + (16 * q + 4 * q4) * 4); mv[4 * q4] = v4.x; mv[4 * q4 + 1] = v4.y; mv[4 * q4 + 2] = v4.z; mv[4 * q4 + 3] = v4.w; }
                } else {
#pragma unroll
                    for (int e = 0; e < 16; ++e) mv[e] = 0.f; }
                float su[16], sw[16];
#pragma unroll
                for (int e = 0; e < 16; ++e) { const int pp = 16 * q + e; const float m = (pp <= p) ? mv[e] : 0.f, bt = bts[d * 64 + pp]; su[e] = m * bt; sw[e] = m * bt * egs[d * 64 + pp]; }
                v4u ou0, ou1, ow0, ow1;
                if (d == 0) { ou0 = (v4u){cvtpk(su[0], su[1]), cvtpk(su[2], su[3]), cvtpk(su[4], su[5]), cvtpk(su[6], su[7])}; ou1 = (v4u){cvtpk(su[8], su[9]), cvtpk(su[10], su[11]), cvtpk(su[12], su[13]), cvtpk(su[14], su[15])};
                              ow0 = (v4u){cvtpk(sw[0], sw[1]), cvtpk(sw[2], sw[3]), cvtpk(sw[4], sw[5]), cvtpk(sw[6], sw[7])}; ow1 = (v4u){cvtpk(sw[8], sw[9]), cvtpk(sw[10], sw[11]), cvtpk(sw[12], sw[13]), cvtpk(sw[14], sw[15])}; }
                else        { ou0 = (v4u){cvtpk(su[15], su[14]), cvtpk(su[13], su[12]), cvtpk(su[11], su[10]), cvtpk(su[9], su[8])}; ou1 = (v4u){cvtpk(su[7], su[6]), cvtpk(su[5], su[4]), cvtpk(su[3], su[2]), cvtpk(su[1], su[0])};
                              ow0 = (v4u){cvtpk(sw[15], sw[14]), cvtpk(sw[13], sw[12]), cvtpk(sw[11], sw[10]), cvtpk(sw[9], sw[8])}; ow1 = (v4u){cvtpk(sw[7], sw[6]), cvtpk(sw[5], sw[4]), cvtpk(sw[3], sw[2]), cvtpk(sw[1], sw[0])}; }
                const int t0 = d ? 48 - 16 * q : 16 * q;
                LAS unsigned char* mu = lds + GD_AD + (d * 2) * 9216 + p * GD_MPP + t0 * 2; LAS unsigned char* mw = mu + 9216;
                LDS_BARRIER();
                *(LAS v4u*)mu = ou0; *(LAS v4u*)(mu + 16) = ou1; *(LAS v4u*)mw = ow0; *(LAS v4u*)(mw + 16) = ow1;
            }
            LDS_BARRIER();
            }
#undef GD_MEL
            if (u + F.G < NB * 8 * 36) {
                asm volatile("" : "+v"(zr[0]), "+v"(zr[1]), "+v"(zr[2]), "+v"(zr[3]), "+v"(zr[4]), "+v"(zr[5]), "+v"(zr[6]), "+v"(zr[7]), "+v"(zr[8]), "+v"(zr[9]), "+v"(zr[10]), "+v"(zr[11]));
                if (wave < 4) asm volatile("" : "+v"(zr[12]), "+v"(zr[13]), "+v"(zr[14]), "+v"(zr[15]), "+v"(zr[16]), "+v"(zr[17]), "+v"(zr[18]), "+v"(zr[19]));
                asm volatile("" : "+v"(cw[0]), "+v"(cw[1]), "+v"(cw[2]), "+v"(cw[3]), "+v"(cw[4]), "+v"(pab0), "+v"(pab1)); }
            for (int repd6 = 0; repd6 < REP_GD6; ++repd6)
            { const int d = wave >> 2, which = (wave >> 1) & 1, ct0 = 4 * (wave & 1);
                const size_t rec = (size_t)((b * 8 + h) * 2 + d) * 36 + c;
                const LAS unsigned char* img = lds + GD_AD + (d * 2 + which) * 9216;
                const unsigned srcb = (unsigned)(size_t)(lds + (which ? GD_KS : GD_VS)) + (unsigned)((8 * g + (cc >> 2)) * GD_PITCH + 8 * (cc & 3));
                bf16x8 afr[2][4];
#pragma unroll
                for (int kb = 0; kb < 2; ++kb)
#pragma unroll
                    for (int mt = 0; mt < 4; ++mt) afr[kb][mt] = *(const LAS bf16x8*)(img + (16 * mt + cc) * GD_MPP + (32 * kb + 8 * g) * 2);
                __builtin_amdgcn_sched_barrier(0);
#pragma unroll
                for (int ctl = 0; ctl < 4; ++ctl) { const int ct = ct0 + ctl;
                    f32x4 acc[4];
#pragma unroll
                    for (int mt = 0; mt < 4; ++mt) acc[mt] = (f32x4){0.f, 0.f, 0.f, 0.f};
                    bf16x8 bfr[2];
#pragma unroll
                    for (int kb = 0; kb < 2; ++kb) { const LAS s16x4* a0 = (const LAS s16x4*)(srcb + (unsigned)(32 * kb * GD_PITCH + 32 * ct));
                        const s16x4 lo = __builtin_amdgcn_ds_read_tr16_b64_v4i16((LAS s16x4*)a0), hi = __builtin_amdgcn_ds_read_tr16_b64_v4i16((LAS s16x4*)((const LAS unsigned char*)a0 + 4 * GD_PITCH));
                        bfr[kb] = __builtin_shufflevector(lo, hi, 0, 1, 2, 3, 4, 5, 6, 7); }
#pragma unroll
                    for (int kb = 0; kb < 2; ++kb)
#pragma unroll
                        for (int mt = 0; mt < 4; ++mt) acc[mt] = __builtin_amdgcn_mfma_f32_16x16x32_bf16(afr[kb][mt], bfr[kb], acc[mt], 0, 0, 0);
                    if (which == 0) { float* U = UB + rec * 8192 + (ct * 64 + lane) * 4;
#pragma unroll
                        for (int mt = 0; mt < 4; ++mt) *(f32x4*)(U + mt * 8 * 256) = acc[mt];
                    } else { LAS unsigned char* W = lds + GD_MD + d * 17408 + (16 * ct + cc) * 2;
#pragma unroll
                        for (int mt = 0; mt < 4; ++mt)
#pragma unroll
                            for (int r = 0; r < 4; ++r) *(LAS bf16*)(W + (16 * mt + 4 * g + r) * GD_PITCH) = (bf16)f2bf(-acc[mt][r]); }
                }
            }
        }
        LDS_BARRIER();
        for (int repe = 0; repe < REP_GE; ++repe) {
            int te_; asm volatile("v_mbcnt_lo_u32_b32 %0, -1, 0\n\tv_mbcnt_hi_u32_b32 %0, -1, %0" : "=v"(te_)); const int lane = te_;
            const int d = wave >> 2, wd = wave & 3, i = lane & 15, g = lane >> 4;
            unsigned char* rec = RECB + ((size_t)((b * 8 + h) * 2 + d) * 36 + c) * GD_REC;
            const LAS unsigned char* W = lds + GD_MD + d * 17408; const LAS unsigned char* QKB = lds + GD_QKB + d * 9216;
            unsigned char* recl = rec + lane * 16;
            { v2u lo[4], hi[4];
#pragma unroll
              for (int mt = 0; mt < 4; ++mt) { const LAS unsigned char* s = W + (16 * mt + i) * GD_PITCH + (32 * wd + 4 * g) * 2; lo[mt] = *(const LAS v2u*)s; hi[mt] = *(const LAS v2u*)(s + 32); }
#pragma unroll
              for (int mt = 0; mt < 4; ++mt) *(v4u*)(recl + (size_t)(4 * mt + wd) * 1024) = (v4u){lo[mt].x, lo[mt].y, hi[mt].x, hi[mt].y}; }
            { v2u lo[4], hi[4]; float sc[4];
#pragma unroll
              for (int mt = 0; mt < 4; ++mt) { const int p = 16 * mt + i, trow = d ? 63 - p : p; sc[mt] = egs[d * 64 + p];
                  const LAS unsigned char* s = lds + GD_QS + trow * GD_PITCH + (32 * wd + 4 * g) * 2; lo[mt] = *(const LAS v2u*)s; hi[mt] = *(const LAS v2u*)(s + 32); }
#pragma unroll
              for (int mt = 0; mt < 4; ++mt) { v4u out; const float c_ = sc[mt];
                  out.x = pk2(bflo(lo[mt].x) * c_, bfhi(lo[mt].x) * c_); out.y = pk2(bflo(lo[mt].y) * c_, bfhi(lo[mt].y) * c_); out.z = pk2(bflo(hi[mt].x) * c_, bfhi(hi[mt].x) * c_); out.w = pk2(bflo(hi[mt].y) * c_, bfhi(hi[mt].y) * c_);
                  *(v4u*)(recl + (size_t)(16 + 4 * mt + wd) * 1024) = out; } }
            { const int kb = wd & 1; float ek[8]; int trw[8];
#pragma unroll
              for (int j = 0; j < 8; ++j) { const int p = 32 * kb + 16 * (j >> 2) + 4 * g + (j & 3); trw[j] = (d ? 63 - p : p) * GD_PITCH; ek[j] = ekd[d * 64 + p]; }
              unsigned short kv[4][8];
#pragma unroll
              for (int jj = 0; jj < 4; ++jj) { const int dk = 16 * (2 * jj + (wd >> 1)) + i;
#pragma unroll
                  for (int j = 0; j < 8; ++j) kv[jj][j] = *(const LAS bf16*)(lds + GD_KS + trw[j] + dk * 2); }
#pragma unroll
              for (int jj = 0; jj < 4; ++jj) { v4u out;
                  out.x = pk2(bf2f(kv[jj][0]) * ek[0], bf2f(kv[jj][1]) * ek[1]); out.y = pk2(bf2f(kv[jj][2]) * ek[2], bf2f(kv[jj][3]) * ek[3]);
                  out.z = pk2(bf2f(kv[jj][4]) * ek[4], bf2f(kv[jj][5]) * ek[5]); out.w = pk2(bf2f(kv[jj][6]) * ek[6], bf2f(kv[jj][7]) * ek[7]);
                  *(v4u*)(recl + (size_t)(32 + 4 * jj + wd) * 1024) = out; } }
            { const int kb = wd & 1; v2u lo[2], hi[2];
#pragma unroll
              for (int jj = 0; jj < 2; ++jj) { const LAS unsigned char* s = QKB + (16 * (2 * jj + (wd >> 1)) + i) * GD_QKP + (32 * kb + 4 * g) * 2; lo[jj] = *(const LAS v2u*)s; hi[jj] = *(const LAS v2u*)(s + 32); }
#pragma unroll
              for (int jj = 0; jj < 2; ++jj) *(v4u*)(recl + (size_t)(48 + 4 * jj + wd) * 1024) = (v4u){lo[jj].x, lo[jj].y, hi[jj].x, hi[jj].y}; }
        }
    }
#undef GD_PREFETCH
}

__device__ __forceinline__ void gdn_scan_phase(const Frame& F0, const Args& a0, int nblk, bool last) {
    const Frame F = relaunder(F0); const Args a = relaunder_args(a0);
    const int chain = F.bx; if (chain >= nblk) return;
    const int d = chain & 1, h = (chain >> 1) & 7, b = chain >> 4;
    const unsigned char* REC = a.ws + WS_GREC + (size_t)chain * 36 * GD_REC; const float* UB = (const float*)(a.ws + WS_GU) + (size_t)chain * 36 * 8192; const float* GLB = (const float*)(a.ws + WS_GL) + (size_t)chain * 36;
    bf16* GOb = (bf16*)(a.ws + WS_GO2) + (size_t)d * M * 1024;
    LAS unsigned char* lds = F.lds + RING_OFF;
    LAS unsigned char* ost = lds + 2 * GD_REC;
    const int lane = F.lane, n = F.wave, cc = lane & 15, g = lane >> 4;
    f32x4 S[8];
#pragma unroll
    for (int t = 0; t < 8; ++t) S[t] = (f32x4){0.f, 0.f, 0.f, 0.f};
#define GD_CHUNK(s) (d ? ((s) < 4 ? 3 - (s) : 39 - (s)) : (s))
#define GD_GLDS(cidx, buf) do { const unsigned char* src_ = REC + (size_t)(cidx) * GD_REC + lane * 16; \
        _Pragma("unroll") for (int k_ = 0; k_ < 7; ++k_) __builtin_amdgcn_global_load_lds((const unsigned*)(src_ + (n + 8 * k_) * 1024), (LAS unsigned*)(lds + (buf) * GD_REC + (n + 8 * k_) * 1024), 16, 0, 0); } while (0)
    f32x4 un[4]; float gln;
    { const int c0 = GD_CHUNK(0); GD_GLDS(c0, 0);
#pragma unroll
      for (int mt = 0; mt < 4; ++mt) un[mt] = *(const f32x4*)(UB + (size_t)c0 * 8192 + ((mt * 8 + n) * 64 + lane) * 4);
      gln = GLB[c0]; }
    VM_WAIT(); __syncthreads();
    int cprev = -1;
#define GD_STORE_ROWS(cidx, buf) do { _Pragma("unroll") for (int i_ = 0; i_ < 2; ++i_) { const int id_ = F.tid + 512 * i_, row_ = id_ >> 4, ch_ = id_ & 15; \
        const v4u v_ = *(const LAS v4u*)(ost + (buf) * 16384 + row_ * 256 + ((ch_ ^ (((row_ >> 2) & 3) << 2)) * 16)); \
        *(v4u*)(GOb + (size_t)(b * TT + 64 * (cidx) + row_) * 1024 + h * 128 + ch_ * 8) = v_; } } while (0)
    for (int s = 0; s < 36; ++s) {
        const int c = GD_CHUNK(s);
        f32x4 V[4]; const float gl = gln;
#pragma unroll
        for (int mt = 0; mt < 4; ++mt) V[mt] = un[mt];
        if (cprev >= 0 && !(last && cprev < 4)) GD_STORE_ROWS(cprev, (s + 1) & 1);
        if (s + 1 < 36) { const int cn = GD_CHUNK(s + 1);
#pragma unroll
            for (int mt = 0; mt < 4; ++mt) un[mt] = *(const f32x4*)(UB + (size_t)cn * 8192 + ((mt * 8 + n) * 64 + lane) * 4);
            gln = GLB[cn];
            GD_GLDS(cn, (s + 1) & 1); }
        const LAS unsigned char* Bf = lds + (s & 1) * GD_REC + lane * 16;
#define GD_FRAG(f) (*(const LAS bf16x8*)(Bf + (f) * 1024))
        bf16x8 fA[8], fB[8], fC[8];
#define GD_LOAD8(dst, f0) do { _Pragma("unroll") for (int i_ = 0; i_ < 8; ++i_) dst[i_] = GD_FRAG((f0) + i_); } while (0)
#define GD_PIN() __builtin_amdgcn_sched_barrier(0)
        GD_LOAD8(fA, 0); GD_LOAD8(fB, 8);
        bf16x8 Sf[4];
#pragma unroll
        for (int kb = 0; kb < 4; ++kb) Sf[kb] = pack8(S[2 * kb], S[2 * kb + 1]);
        f32x4 O[4];
#pragma unroll
        for (int mt = 0; mt < 4; ++mt) O[mt] = (f32x4){0.f, 0.f, 0.f, 0.f};
        GD_PIN();
#pragma unroll
        for (int i = 0; i < 8; ++i) V[i >> 2] = __builtin_amdgcn_mfma_f32_16x16x32_bf16(fA[i], Sf[i & 3], V[i >> 2], 0, 0, 0);
        GD_PIN(); GD_LOAD8(fC, 16); GD_PIN();
#pragma unroll
        for (int i = 0; i < 8; ++i) V[2 + (i >> 2)] = __builtin_amdgcn_mfma_f32_16x16x32_bf16(fB[i], Sf[i & 3], V[2 + (i >> 2)], 0, 0, 0);
        GD_PIN(); GD_LOAD8(fA, 24); GD_PIN();
#pragma unroll
        for (int i = 0; i < 8; ++i) O[i >> 2] = __builtin_amdgcn_mfma_f32_16x16x32_bf16(fC[i], Sf[i & 3], O[i >> 2], 0, 0, 0);
        GD_PIN(); GD_LOAD8(fB, 32); GD_PIN();
#pragma unroll
        for (int i = 0; i < 8; ++i) O[2 + (i >> 2)] = __builtin_amdgcn_mfma_f32_16x16x32_bf16(fA[i], Sf[i & 3], O[2 + (i >> 2)], 0, 0, 0);
        GD_PIN(); GD_LOAD8(fC, 40); GD_PIN();
        bf16x8 Vf[2]; Vf[0] = pack8(V[0], V[1]); Vf[1] = pack8(V[2], V[3]);
#pragma unroll
        for (int t = 0; t < 8; ++t) S[t] = S[t] * gl;
#pragma unroll
        for (int i = 0; i < 8; ++i) S[i >> 1] = __builtin_amdgcn_mfma_f32_16x16x32_bf16(fB[i], Vf[i & 1], S[i >> 1], 0, 0, 0);
        GD_PIN();
#pragma unroll
        for (int i_ = 0; i_ < 8; ++i_) if (i_ != 1 && i_ != 3) fA[i_] = GD_FRAG(48 + i_);
        GD_PIN();
#pragma unroll
        for (int i = 0; i < 8; ++i) S[4 + (i >> 1)] = __builtin_amdgcn_mfma_f32_16x16x32_bf16(fC[i], Vf[i & 1], S[4 + (i >> 1)], 0, 0, 0);
#pragma unroll
        for (int i = 0; i < 8; ++i) if (i != 1 && i != 3) O[i >> 1] = __builtin_amdgcn_mfma_f32_16x16x32_bf16(fA[i], Vf[i & 1], O[i >> 1], 0, 0, 0);
#undef GD_PIN
#undef GD_LOAD8
#undef GD_FRAG
        if (!(last && c < 4)) {
            LAS unsigned char* ob = ost + (s & 1) * 16384;
            const bool ev = !(cc & 1);
#pragma unroll
            for (int mt = 0; mt < 4; ++mt) {
                const float s0 = ev ? O[mt][2] : O[mt][0], s1 = ev ? O[mt][3] : O[mt][1];
                const float r0 = __builtin_bit_cast(float, __builtin_amdgcn_mov_dpp(__builtin_bit_cast(int, s0), 0xB1, 0xF, 0xF, true));
                const float r1 = __builtin_bit_cast(float, __builtin_amdgcn_mov_dpp(__builtin_bit_cast(int, s1), 0xB1, 0xF, 0xF, true));
                const unsigned w0 = ev ? pk2(O[mt][0], r0) : pk2(r0, O[mt][2]), w1 = ev ? pk2(O[mt][1], r1) : pk2(r1, O[mt][3]);
#pragma unroll
                for (int e = 0; e < 2; ++e) { const int p = 16 * mt + 4 * g + (ev ? 0 : 2) + e, tok = d ? 63 - p : p;
                    *(LAS unsigned*)(ob + tok * 256 + (((2 * n + (cc >> 3)) ^ (((tok >> 2) & 3) << 2)) * 16) + (cc & 6) * 2) = e ? w1 : w0; } }
        }
        cprev = c;
        if (REP_SLEEP) __builtin_amdgcn_s_sleep(REP_SLEEP);
        VM_WAIT(); __syncthreads();
    }
    if (!(last && cprev < 4)) GD_STORE_ROWS(cprev, 35 & 1);
#undef GD_CHUNK
#undef GD_GLDS
#undef GD_STORE_ROWS
}

__device__ __forceinline__ void gdn_out_phase(const Frame& F0, const Args& a0, int l, bool last) {
    const Frame F = relaunder(F0); const Args a = relaunder_args(a0);
    const bf16* GO = (const bf16*)(a.ws + WS_GO2); const bf16* Z = (const bf16*)(a.ws + WS_Z); bf16* MIX = (bf16*)(a.ws + WS_MIX);
    const float* gnorm = a.in[I_GNORM] + l * 128;
    const int gw = F.vcu * NWAVES + F.wave, NGW = F.G * NWAVES;
    f32x4 gn[4];
#pragma unroll
    for (int k = 0; k < 4; ++k) gn[k] = *(const f32x4*)(gnorm + (((F.lane + 64 * k) * 4) & 127));
    for (int m0 = gw; m0 < M; m0 += 2 * NGW) {
        const int m1 = m0 + NGW;
        const bool ok0 = !(last && (m0 % TT) < CTXL), ok1 = m1 < M && !(last && (m1 % TT) < CTXL);
        v2u oa[2][4], ob[2][4], gz[2][4];
#define GO_LOAD(e, m) do { _Pragma("unroll") for (int k = 0; k < 4; ++k) { const int ch = (F.lane + 64 * k) * 4; \
            oa[e][k] = *(const v2u*)(GO + (size_t)(m) * 1024 + ch); ob[e][k] = *(const v2u*)(GO + (size_t)M * 1024 + (size_t)(m) * 1024 + ch); gz[e][k] = *(const v2u*)(Z + (size_t)(m) * ZP + OFF_GATE + ch); } } while (0)
#define GO_ROW(e, m) do { _Pragma("unroll") for (int k = 0; k < 4; ++k) { const int ch = (F.lane + 64 * k) * 4; \
            const f32x4 o = (f32x4){bflo(oa[e][k].x) + bflo(ob[e][k].x), bfhi(oa[e][k].x) + bfhi(ob[e][k].x), bflo(oa[e][k].y) + bflo(ob[e][k].y), bfhi(oa[e][k].y) + bfhi(ob[e][k].y)}; \
            float ss = (o.x * o.x + o.y * o.y) + (o.z * o.z + o.w * o.w); \
            _Pragma("unroll") for (int q = 1; q < 32; q <<= 1) ss += shx(ss, q, F.lane); \
            const float rn = 1.0f / sqrtf(ss * (1.f / 128.f) + EPS); \
            const float g0 = bflo(gz[e][k].x), g1 = bfhi(gz[e][k].x), g2 = bflo(gz[e][k].y), g3 = bfhi(gz[e][k].y); \
            v2u w; w.x = pk2(o.x * rn * gn[k].x * siluf(g0), o.y * rn * gn[k].y * siluf(g1)); \
            w.y = pk2(o.z * rn * gn[k].z * siluf(g2), o.w * rn * gn[k].w * siluf(g3)); \
            *(v2u*)(MIX + (size_t)(m) * 2048 + 1024 + ch) = w; } } while (0)
        if (ok0) GO_LOAD(0, m0);
        if (ok1) GO_LOAD(1, m1);
        __builtin_amdgcn_sched_barrier(0);
        if (ok0) GO_ROW(0, m0);
        if (ok1) GO_ROW(1, m1);
#undef GO_LOAD
#undef GO_ROW
    }
}

__global__ void __launch_bounds__(NTHREADS, 2) fwd(Args args) {
    extern __shared__ __attribute__((aligned(16))) unsigned char lds[];
    Frame F;
    F.lds = (LAS unsigned char*)lds;
    F.wave = __builtin_amdgcn_readfirstlane((int)threadIdx.x >> 6); F.tid = 0; F.lane = 0;
    F.G = gridDim.x; F.bx = blockIdx.x; { const int bx = blockIdx.x; F.vcu = (F.G % 8 == 0) ? (bx % 8) * (F.G / 8) + bx / 8 : bx; }
    unsigned char* ws = args.ws;
    const int lo = args.gp_lo, hi = args.gp_hi;
    for (int u = threadIdx.x; u < (LDS_BYTES - LDSCTL_OFF) / 4; u += NTHREADS) ((LAS unsigned*)(F.lds + LDSCTL_OFF))[u] = 0u;
    __syncthreads();
    XcdBarrier bar = xcd_barrier_post((unsigned*)(ws + WS_CTL) + CW_BAR + args.bar_region * XCD_BAR_WORDS, (volatile LAS unsigned*)(F.lds + MISC_OFF) + 8);
#define IN(g) (lo <= (g) && (g) < hi)
#define SEAM(g) do { if (IN(g) && IN((g) + 1)) xcd_barrier(bar); } while (0)
    if (IN(0)) for (int rep = 0; rep < REP_PRO; ++rep) { p0_prologue(F, args); if (rep + 1 < REP_PRO) xcd_barrier(bar); }
    SEAM(0);
    for (int l = 0; l < DEPTH; ++l) {
        const bool last = (l == DEPTH - 1);
        const float* modl = (const float*)(ws + WS_MOD) + (size_t)l * 5 * D6;
        const float* zmod = (const float*)(ws + WS_ZERO);
        if (IN(GP(l, 0))) for (int rep = 0; rep < REP_NORM; ++rep) { norm_mod_phase(F, args, l, 0, false, (l > 0 && rep == 0) ? modl - 5 * D6 + 3 * D6 + 5 * DM : nullptr); if (REP_NB && rep + 1 < REP_NORM) xcd_barrier(bar); }
        SEAM(GP(l, 0)); if (REP_BAR > 1) SEAM(GP(l, 0));
        if (IN(GP(l, 1))) {
          for (int rep = 0; rep < REP_GEMM * REP_G1; ++rep) {
            unsigned char* ws = relaunder_args(args).ws; const Frame Fg = relaunder(F);
            pg8::Gemm g{(const bf16*)(ws + WS_H), (const bf16*)(ws + WS_WIN) + (size_t)l * D_INP * DM, M, D_INP, DM};
            pg8::Gemm1Order S; S.init(Fg.G, Fg.bx, 0);
            pg8::EpiZ E{(bf16*)(ws + WS_Z), (float*)(ws + WS_AB), (const float*)(ws + WS_ROPE)};
            pg8::gemm_phase<pg8::EpiZ, pg8::Gemm1Order, true, true>(F.lds + RING_OFF, g, S, E, Fg.tid);
            if (rep + 1 < REP_GEMM * REP_G1) xcd_barrier(bar);
          }
        }
        SEAM(GP(l, 1));
        if (IN(GP(l, 2))) for (int rep = 0; rep < REP_MIX * REP_PREP; ++rep) { gdn_prep_phase(F, args, l);
            if (rep == 0 && CV_PREP > 0 && F.vcu >= 128) { __syncthreads(); cv_deferred<2>(F, args, l, 0, CV_PREP, (F.vcu - 128) * NWAVES + F.wave, 128 * NWAVES); }
            if (rep + 1 < REP_MIX * REP_PREP) xcd_barrier(bar); }
        SEAM(GP(l, 2)); if (REP_BAR > 1) SEAM(GP(l, 2));
        if (IN(GP(l, 3))) for (int rep = 0; rep < REP_MIX; ++rep) {
            for (int r2 = 0; r2 < REP_SCAN; ++r2) gdn_scan_phase(F, args, 64, last);
            if (F.bx >= 64 && F.bx < 124) {
                unsigned char* ws = relaunder_args(args).ws; const Frame Fg = relaunder(F);
                pg8::Gemm g{(const bf16*)(ws + WS_H), (const bf16*)(ws + WS_WIN) + (size_t)l * D_INP * DM, M, D_INP, DM};
                pg8::Gemm1Order S; S.init(Fg.G, Fg.bx - 64, 1);
                pg8::EpiZ E{(bf16*)(ws + WS_Z), (float*)(ws + WS_AB), (const float*)(ws + WS_ROPE)};
                pg8::gemm_phase<pg8::EpiZ, pg8::Gemm1Order, true, true>(F.lds + RING_OFF, g, S, E, Fg.tid);
                __syncthreads();
            }
            for (int r2 = 0; r2 < REP_ATTN; ++r2) {
                if (F.bx >= 64 && F.bx < 124) attn_phase(F, args, l, F.bx - 64, 1, 1, 512, 512 + (F.bx - 64), last);
                else if (F.bx >= 124) attn_phase(F, args, l, 60 + (F.bx - 124), 132, 4, 512, F.bx >= 252 ? 572 + (F.bx - 252) : -1, last); }
            if (rep == 0 && CV_P3 > 0 && F.bx >= 180) { __syncthreads(); cv_deferred<2>(F, args, l, CV_PREP, CV_P3, (F.bx - 180) * NWAVES + F.wave, 76 * NWAVES); }
            if (rep + 1 < REP_MIX) xcd_barrier(bar); }
        SEAM(GP(l, 3));
        if (IN(GP(l, 4))) for (int rep = 0; rep < REP_MIX * REP_OUT; ++rep) gdn_out_phase(F, args, l, last);
        SEAM(GP(l, 4)); if (REP_BAR > 1) SEAM(GP(l, 4));
        if (IN(GP(l, 5))) {
          for (int rep = 0; rep < REP_GEMM * REP_G2; ++rep) {
            unsigned char* ws = relaunder_args(args).ws; const Frame Fg = relaunder(F);
            pg8::Gemm g{(const bf16*)(ws + WS_MIX), (const bf16*)(ws + WS_WOUT) + (size_t)l * DM * DM, M, DM, DM};
            pg8::PanelOrder S; S.init2(last ? 32 : 36, DM, DM, Fg.G, Fg.bx, last ? 1 : 0, 8);
            pg8::EpiGate E{(float*)(ws + WS_X), rep ? zmod : modl, 2 * DM, DM / 64, (float*)(ws + WS_SLAB)};
            pg8::gemm_phase<pg8::EpiGate, pg8::PanelOrder, true, true>(F.lds + RING_OFF, g, S, E, Fg.tid);
            if (rep + 1 < REP_GEMM * REP_G2) xcd_barrier(bar);
          }
        }
        SEAM(GP(l, 5));
        if (IN(GP(l, 6))) for (int rep = 0; rep < REP_NORM; ++rep) norm_mod_phase(F, args, l, 1, last, (last || rep) ? nullptr : modl + 3 * D6 + 2 * DM);
        SEAM(GP(l, 6)); if (REP_BAR > 1) SEAM(GP(l, 6));
        if (IN(GP(l, 7))) {
          for (int rep = 0; rep < REP_GEMM * REP_G3; ++rep) {
            unsigned char* ws = relaunder_args(args).ws; const Frame Fg = relaunder(F);
            pg8::Gemm g{(const bf16*)(ws + WS_H), (const bf16*)(ws + WS_W1) + (size_t)l * DFF * DM, M, DFF, DM};
            pg8::PanelOrder S; S.init2(last ? 32 : 36, DFF, DM, Fg.G, Fg.bx, last ? 1 : 0, 1); S.consttile = (rep > 0) ? REP_CT : 0;
            pg8::EpiSq E{(bf16*)(ws + (rep > 0 && REP_CT ? WS_GQ : WS_FFH)), DFF};
            if (rep > 0 && REP_CT == 2) { g.K = DM; S.ntk = 16; }
            pg8::gemm_phase<pg8::EpiSq, pg8::PanelOrder, true, true>(F.lds + RING_OFF, g, S, E, Fg.tid);
            if (!last && rep == 0 && CV_DEFER > 0 && F.bx >= 128) { __syncthreads(); cv_deferred<1>(F, args, l + 1, 0, CV_DEFER, (F.bx - 128) * NWAVES + F.wave, 128 * NWAVES); }
            if (rep + 1 < REP_GEMM * REP_G3) xcd_barrier(bar);
          }
        }
        SEAM(GP(l, 7));
        if (IN(GP(l, 8))) {
          for (int rep = 0; rep < REP_GEMM * REP_G4; ++rep) {
            unsigned char* ws = relaunder_args(args).ws; const Frame Fg = relaunder(F);
            pg8::Gemm g{(const bf16*)(ws + WS_FFH), (const bf16*)(ws + WS_W2) + (size_t)l * DM * DFF, M, DM, DFF};
            pg8::PanelOrder S; S.init2(last ? 32 : 36, DM, DFF, Fg.G, Fg.bx, last ? 1 : 0, 8);
            pg8::EpiGate E{(float*)(ws + WS_X), rep ? zmod : modl, 5 * DM, DFF / 64, (float*)(ws + WS_SLAB)};
            pg8::gemm_phase<pg8::EpiGate, pg8::PanelOrder, true, true>(F.lds + RING_OFF, g, S, E, Fg.tid);
            if (rep + 1 < REP_GEMM * REP_G4) xcd_barrier(bar);
          }
        }
        SEAM(GP(l, 8));
    }
    if (IN(GP_FINAL)) for (int rep = 0; rep < REP_FIN; ++rep) final_norm_phase(F, args);
#undef IN
#undef SEAM
}

static void launch_fwd(const Args& base, int lo, int hi, int region, int grid, hipStream_t stream) {
    Args a = base; a.gp_lo = lo; a.gp_hi = hi; a.bar_region = region;
    hipLaunchKernelGGL(fwd, dim3(grid), dim3(NTHREADS), LDS_BYTES, stream, a);
}
extern "C" void kernel_launch(void* const* d_in, const int* in_sizes, int n_in, void* d_out, int out_size, void* d_ws, size_t ws_size, hipStream_t stream) {
    static int grid = 0;
    if (grid == 0) {
        if (n_in != 18 || out_size != NB * SEQ * DM || ws_size < WS_END) { fprintf(stderr, "kernel_launch: unexpected shapes (n_in %d out %d ws %zu)\n", n_in, out_size, ws_size); grid = -1; return; }
        int dev = 0, cus = 0;
        if (hipGetDevice(&dev) != hipSuccess || hipDeviceGetAttribute(&cus, hipDeviceAttributeMultiprocessorCount, dev) != hipSuccess) { grid = -1; return; }
        if (hipFuncSetAttribute((const void*)fwd, hipFuncAttributeMaxDynamicSharedMemorySize, LDS_BYTES) != hipSuccess) { fprintf(stderr, "kernel_launch: hipFuncSetAttribute failed\n"); grid = -1; return; }
        (void)hipGetLastError();
        grid = cus;
    }
    if (grid < 0) return;
    unsigned char* ws = (unsigned char*)d_ws;
    (void)hipMemsetAsync(ws + WS_CTL, 0, CTL_ZERO_BYTES, stream);
    if (REP_GEMM * REP_G2 * REP_G4 > 1) (void)hipMemsetAsync(ws + WS_ZERO, 0, 1 * MiB, stream);
    Args a{};
    for (int i = 0; i < 18; ++i) a.in[i] = (const float*)d_in[i];
    a.out = (float*)d_out; a.ws = ws;
    launch_fwd(a, 0, GP_FINAL + 1, 0, grid, stream);
}
```
